# Optimizing an MI355X kernel written in HIP

```python
import math, functools
import jax, jax.numpy as jnp
from jax import lax
import numpy as np

D_MODEL = 2048
BATCH = 2
SEQ = 4096
DEPTH = 2
DEC_BATCH = 32
DEC_SEQ = 4
PAST_LEN = 16384
PAGE_SIZE = 128

N_META = 16
EPS = 1e-6
NEG_INF = -1e30
LB_FLOOR = 1e-30
WINDOW = 128
ATTN_BLOCK = 128
HEAD_DIM_A = 64
N_HEADS_A = (D_MODEL // 2) // HEAD_DIM_A
N_KV_A = 4
GROUP_A = N_HEADS_A // N_KV_A
N_ROT = HEAD_DIM_A // 4
ROPE_THETA = 500000.0
H_B = 4
DK_B = 128
DV_B = (D_MODEL // 4) // H_B
H_C = 4
DK_C = (D_MODEL // 4) // H_C
DV_C = DK_C
RET_THETA = 10000.0
CHUNK = 64
Q_A_W = N_HEADS_A * HEAD_DIM_A
KV_A_W = N_KV_A * HEAD_DIM_A
W_B = H_B * DK_B
W_C = H_C * DK_C
IN_SIZES = (Q_A_W, KV_A_W, KV_A_W, W_B, W_B, H_B * DV_B, H_B * DV_B, W_C, W_C, H_C * DV_C, H_C * DV_C)
D_IN = sum(IN_SIZES)
D_MIX = Q_A_W + H_B * DV_B + H_C * DV_C
D_FF = -(-8 * D_MODEL // (3 * 256)) * 256

kernel_name = 'hymba_swa_hgrn2_retention_step'


def _rmsnorm(x, g):
    xf = x.astype(jnp.float32)
    y = xf * lax.rsqrt(jnp.mean(xf * xf, axis=-1, keepdims=True) + EPS)
    return (y * g.astype(jnp.float32)).astype(x.dtype)


def _rope(x, pos, n_rot, theta):
    half = n_rot // 2
    inv = theta ** (-jnp.arange(half, dtype=jnp.float32) * (2.0 / n_rot))
    ang = pos.astype(jnp.float32)[:, None] * inv[None, :]
    cos = jnp.cos(ang)[:, None, :]
    sin = jnp.sin(ang)[:, None, :]
    xf = x.astype(jnp.float32)
    x1 = xf[..., :half]
    x2 = xf[..., half:n_rot]
    parts = [x1 * cos - x2 * sin, x2 * cos + x1 * sin]
    if n_rot < x.shape[-1]:
        parts.append(xf[..., n_rot:])
    return jnp.concatenate(parts, axis=-1).astype(x.dtype)


def _lower_bounds(lb_param):
    p = jax.nn.softmax(lb_param.astype(jnp.float32), axis=0)
    return jnp.cumsum(p, axis=0) - p[0]


def _mixer_inputs(h, pos, w_in_l, qn, kn, lb):
    B, T, _ = h.shape
    idx = np.cumsum(IN_SIZES)[:-1].tolist()
    qa, ka, va, qb, fb, ib, gb, qc, kc, vc, gc = jnp.split(h @ w_in_l, idx, axis=-1)
    qa = _rope(_rmsnorm(qa.reshape(B, T, N_HEADS_A, HEAD_DIM_A), qn), pos, N_ROT, ROPE_THETA)
    ka = _rope(_rmsnorm(ka.reshape(B, T, N_KV_A, HEAD_DIM_A), kn), pos, N_ROT, ROPE_THETA)
    va = va.reshape(B, T, N_KV_A, HEAD_DIM_A)
    lbf = lb.astype(jnp.float32)
    log_lb = jnp.log(jnp.maximum(lbf, LB_FLOOR))
    logf = jnp.logaddexp(log_lb, jnp.log1p(-lbf) + jax.nn.log_sigmoid(fb.astype(jnp.float32)))
    kb = (-jnp.expm1(logf)).reshape(B, T, H_B, DK_B)
    logf = logf.reshape(B, T, H_B, DK_B)
    qb = jax.nn.silu(qb).reshape(B, T, H_B, DK_B)
    vb = ib.reshape(B, T, H_B, DV_B)
    qc = _rope(qc.reshape(B, T, H_C, DK_C), pos, DK_C, RET_THETA)
    kc = _rope(kc.reshape(B, T, H_C, DK_C), pos, DK_C, RET_THETA) * (DK_C ** -0.5)
    vc = vc.reshape(B, T, H_C, DV_C)
    return (qa, ka, va), (qb, kb, vb, logf), (qc, kc, vc), gb, gc


def _sink_attend(q, k, v, mask, sinks):
    scale = q.shape[-1] ** -0.5
    s = jnp.einsum('...qhgd,...khd->...hgqk', q.astype(jnp.float32), k.astype(jnp.float32)) * scale
    s = jnp.where(mask, s, NEG_INF)
    sk = sinks.astype(jnp.float32)[:, :, None, None]
    m = jnp.maximum(jnp.max(s, axis=-1, keepdims=True), sk)
    p = jnp.exp(s - m)
    w = p / (jnp.sum(p, axis=-1, keepdims=True) + jnp.exp(sk - m))
    return jnp.einsum('...hgqk,...khd->...qhgd', w, v.astype(jnp.float32))


def _swa_prompt(q, k, v, sinks):
    B, L, H, D = q.shape
    pad = ATTN_BLOCK - N_META
    nb = (L + pad) // ATTN_BLOCK

    def blocks(a):
        a = jnp.pad(a, ((0, 0), (pad, 0), (0, 0), (0, 0)))
        return a.reshape((B, nb, ATTN_BLOCK) + a.shape[2:])

    qb = blocks(q).reshape(B, nb, ATTN_BLOCK, N_KV_A, GROUP_A, D)
    kb = blocks(k)
    vb = blocks(v)
    kk = jnp.concatenate([jnp.concatenate([jnp.zeros_like(kb[:, :1]), kb[:, :-1]], axis=1), kb], axis=2)
    vv = jnp.concatenate([jnp.concatenate([jnp.zeros_like(vb[:, :1]), vb[:, :-1]], axis=1), vb], axis=2)
    qpos = (jnp.arange(nb * ATTN_BLOCK) - pad).reshape(nb, ATTN_BLOCK)
    kpos = jnp.concatenate([qpos - ATTN_BLOCK, qpos], axis=1)
    d = qpos[:, :, None] - kpos[:, None, :]
    mask = (kpos[:, None, :] >= 0) & (d >= 0) & (d < WINDOW)
    o = _sink_attend(qb, kk, vv, mask[:, None, None], sinks.reshape(N_KV_A, GROUP_A))
    return o.reshape(B, nb * ATTN_BLOCK, H * D)[:, pad:]


def _swa_sample(q, k, v, ck, cv, sinks):
    B, T, H, D = q.shape
    W = ck.shape[1]
    kk = jnp.concatenate([ck, k], axis=1)
    vv = jnp.concatenate([cv, v], axis=1)
    qpos = PAST_LEN + jnp.arange(T)
    kpos = jnp.concatenate([PAST_LEN - W + jnp.arange(W), qpos])
    d = qpos[:, None] - kpos[None, :]
    mask = (d >= 0) & (d < WINDOW)
    o = _sink_attend(q.reshape(B, T, N_KV_A, GROUP_A, D), kk, vv, mask, sinks.reshape(N_KV_A, GROUP_A))
    return o.reshape(B, T, H * D), kk[:, -W:], vv[:, -W:]


def _hgrn_chunk(S, q, k, v, logf):
    q, k, v, logf = (a.astype(jnp.float32) for a in (q, k, v, logf))
    L = q.shape[1]
    G = jnp.cumsum(logf, axis=1)
    inter = jnp.einsum('blhk,bhkv->blhv', q * jnp.exp(G), S)
    causal = jnp.tril(jnp.ones((L, L), bool))[None, :, :, None, None]
    diff = G[:, :, None] - G[:, None, :]
    dec = jnp.where(causal, jnp.exp(jnp.where(causal, diff, 0.0)), 0.0)
    a = jnp.sum(q[:, :, None] * k[:, None, :] * dec, axis=-1)
    intra = jnp.einsum('bqsh,bshv->bqhv', a, v)
    g_last = G[:, -1]
    S_new = jnp.exp(g_last)[..., None] * S + jnp.einsum('bshk,bshv->bhkv', k * jnp.exp(g_last[:, None] - G), v)
    return S_new, inter + intra


def _ret_chunk(lg, S, q, k, v):
    q, k, v = (a.astype(jnp.float32) for a in (q, k, v))
    L = q.shape[1]
    j = jnp.arange(L, dtype=jnp.float32)
    inter = jnp.einsum('blhk,bhkv->blhv', q, S) * jnp.exp((j + 1.0)[:, None] * lg)[None, :, :, None]
    rel = j[:, None] - j[None, :]
    causal = rel >= 0
    dec = jnp.where(causal[..., None], jnp.exp(jnp.where(causal, rel, 0.0)[..., None] * lg), 0.0)
    a = jnp.einsum('bqhk,bshk->bqsh', q, k) * dec
    intra = jnp.einsum('bqsh,bshv->bqhv', a, v)
    tail = jnp.exp((L - 1.0 - j)[:, None] * lg)
    S_new = jnp.exp(L * lg)[None, :, None, None] * S + jnp.einsum('bshk,bshv->bhkv', k * tail[None, :, :, None], v)
    return S_new, inter + intra


def _chunked(fn, S0, seqs):
    B = seqs[0].shape[0]
    S, o_head = fn(S0, *[a[:, :N_META] for a in seqs])
    rest = [a[:, N_META:] for a in seqs]
    n = rest[0].shape[1] // CHUNK
    xs = tuple(jnp.moveaxis(a.reshape((B, n, CHUNK) + a.shape[2:]), 1, 0) for a in rest)
    S, o = lax.scan(lambda s, c: fn(s, *c), S, xs)
    o = jnp.moveaxis(o, 0, 1).reshape((B, n * CHUNK) + o.shape[3:])
    return S, jnp.concatenate([o_head, o], axis=1)


def _finish(x, attn, ob, gb, oc, gc, hn, rn, w_o, nf, wg, wu, wd):
    B, T, _ = x.shape
    yb = (_rmsnorm(ob, hn) * jax.nn.silu(gb.reshape(B, T, H_B, DV_B).astype(jnp.float32))).reshape(B, T, H_B * DV_B)
    yc = (_rmsnorm(oc, rn) * jax.nn.silu(gc.reshape(B, T, H_C, DV_C).astype(jnp.float32))).reshape(B, T, H_C * DV_C)
    mix = jnp.concatenate([attn.astype(jnp.float32), yb, yc], axis=-1)
    x = x + (mix @ w_o).astype(x.dtype)
    h2 = _rmsnorm(x, nf)
    ff = (jax.nn.silu(h2 @ wg) * (h2 @ wu)) @ wd
    return x + ff.astype(x.dtype)


def setup_inputs(seed: int = 0) -> dict:
    key = jax.random.key(seed)
    ks = jax.random.split(key, 20)
    W = min(WINDOW, PAST_LEN)

    def nrm(k, shape, scale):
        return jax.random.normal(k, shape, jnp.float32) * scale

    return {
        'x_prompt': nrm(ks[0], (BATCH, SEQ, D_MODEL), 1.0),
        'x_sample': nrm(ks[1], (DEC_BATCH, DEC_SEQ, D_MODEL), 1.0),
        'cache_k': nrm(ks[2], (DEPTH, DEC_BATCH, W, N_KV_A, HEAD_DIM_A), 1.0),
        'cache_v': nrm(ks[3], (DEPTH, DEC_BATCH, W, N_KV_A, HEAD_DIM_A), 1.0),
        'state_hgrn': nrm(ks[4], (DEPTH, DEC_BATCH, H_B, DK_B, DV_B), 0.5),
        'state_ret': nrm(ks[5], (DEPTH, DEC_BATCH, H_C, DK_C, DV_C), 0.5),
        'meta_tokens': nrm(ks[6], (N_META, D_MODEL), 1.0),
        'norm_mix': 1.0 + nrm(ks[7], (DEPTH, D_MODEL), 0.02),
        'norm_ffn': 1.0 + nrm(ks[8], (DEPTH, D_MODEL), 0.02),
        'w_in': nrm(ks[9], (DEPTH, D_MODEL, D_IN), D_MODEL ** -0.5),
        'q_norm': 1.0 + nrm(ks[10], (DEPTH, HEAD_DIM_A), 0.02),
        'k_norm': 1.0 + nrm(ks[11], (DEPTH, HEAD_DIM_A), 0.02),
        'attn_sinks': nrm(ks[12], (DEPTH, N_HEADS_A), 0.5),
        'hgrn_lb': nrm(ks[13], (DEPTH, W_B), 0.5),
        'hgrn_norm': 1.0 + nrm(ks[14], (DEPTH, DV_B), 0.02),
        'ret_norm': 1.0 + nrm(ks[15], (DEPTH, DV_C), 0.02),
        'w_out': nrm(ks[16], (DEPTH, D_MIX, D_MODEL), D_MIX ** -0.5),
        'w_gate': nrm(ks[17], (DEPTH, D_MODEL, D_FF), D_MODEL ** -0.5),
        'w_up': nrm(ks[18], (DEPTH, D_MODEL, D_FF), D_MODEL ** -0.5),
        'w_down': nrm(ks[19], (DEPTH, D_FF, D_MODEL), D_FF ** -0.5),
    }


def reference(x_prompt, x_sample, cache_k, cache_v, state_hgrn, state_ret, meta_tokens, norm_mix, norm_ffn,
              w_in, q_norm, k_norm, attn_sinks, hgrn_lb, hgrn_norm, ret_norm, w_out, w_gate, w_up, w_down):
    lbs = _lower_bounds(hgrn_lb)
    lg = jnp.log1p(-jnp.exp2(-5.0 - jnp.arange(H_C, dtype=jnp.float32)))
    ret_fn = functools.partial(_ret_chunk, lg)

    B = x_prompt.shape[0]
    meta = jnp.broadcast_to(meta_tokens.astype(x_prompt.dtype)[None], (B, N_META, meta_tokens.shape[-1]))
    xp = jnp.concatenate([meta, x_prompt], axis=1)
    L = xp.shape[1]
    W_p = min(WINDOW, L)
    pos_p = jnp.arange(L)
    xs = x_sample
    pos_s = PAST_LEN + jnp.arange(xs.shape[1])

    ck_p, cv_p, sh_p, sr_p = [], [], [], []
    ck_s, cv_s, sh_s, sr_s = [], [], [], []
    for l in range(DEPTH):
        h = _rmsnorm(xp, norm_mix[l])
        (qa, ka, va), (qb, kb, vb, lf), (qc, kc, vc), gb, gc = _mixer_inputs(h, pos_p, w_in[l], q_norm[l], k_norm[l], lbs[l])
        attn = _swa_prompt(qa, ka, va, attn_sinks[l])
        sb, ob = _chunked(_hgrn_chunk, jnp.zeros((B, H_B, DK_B, DV_B), jnp.float32), (qb, kb, vb, lf))
        sc, oc = _chunked(ret_fn, jnp.zeros((B, H_C, DK_C, DV_C), jnp.float32), (qc, kc, vc))
        xp = _finish(xp, attn, ob, gb, oc, gc, hgrn_norm[l], ret_norm[l], w_out[l], norm_ffn[l], w_gate[l], w_up[l], w_down[l])
        ck_p.append(ka[:, -W_p:])
        cv_p.append(va[:, -W_p:])
        sh_p.append(sb)
        sr_p.append(sc)

        h = _rmsnorm(xs, norm_mix[l])
        (qa, ka, va), (qb, kb, vb, lf), (qc, kc, vc), gb, gc = _mixer_inputs(h, pos_s, w_in[l], q_norm[l], k_norm[l], lbs[l])
        attn, nk, nv = _swa_sample(qa, ka, va, cache_k[l], cache_v[l], attn_sinks[l])
        sb, ob = _hgrn_chunk(state_hgrn[l].astype(jnp.float32), qb, kb, vb, lf)
        sc, oc = ret_fn(state_ret[l].astype(jnp.float32), qc, kc, vc)
        xs = _finish(xs, attn, ob, gb, oc, gc, hgrn_norm[l], ret_norm[l], w_out[l], norm_ffn[l], w_gate[l], w_up[l], w_down[l])
        ck_s.append(nk)
        cv_s.append(nv)
        sh_s.append(sb)
        sr_s.append(sc)

    y_prompt = xp[:, N_META:]
    y_sample = xs
    return (y_prompt, y_sample,
            jnp.stack(ck_p), jnp.stack(cv_p), jnp.stack(sh_p), jnp.stack(sr_p),
            jnp.stack(ck_s), jnp.stack(cv_s), jnp.stack(sh_s), jnp.stack(sr_s))
```

```cpp
#include <hip/hip_runtime.h>
#include <hip/hip_cooperative_groups.h>
#include <cstdio>
#include <cstdint>
#include <cmath>
namespace cg = cooperative_groups;

#define LAS __attribute__((address_space(3)))
typedef unsigned short bf16_t;
typedef short bf16x8 __attribute__((ext_vector_type(8)));
typedef float f32x4 __attribute__((ext_vector_type(4)));
typedef unsigned u32x2 __attribute__((ext_vector_type(2)));
typedef unsigned u32x4 __attribute__((ext_vector_type(4)));

constexpr int D = 2048, DIN = 5632, DFF = 5632, LP = 4112, NPROMPT = 2 * LP  , NSAMP = 128, NTOK = NPROMPT + NSAMP  , MP = 8448;
constexpr int PAST = 16384;
constexpr float EPS = 1e-6f;
constexpr int C_QA = 0, C_KA = 1024, C_VA = 1280, C_QB = 1536, C_FB = 2048, C_IB = 2560, C_GB = 3072, C_QC = 3584, C_KC = 4096, C_VC = 4608, C_GC = 5120;
constexpr size_t O_YP = 0, O_YS = 16777216, O_CKP = 17039360, O_CVP = 17170432, O_SHP = 17301504, O_SRP = 17563648, O_CKS = 17825792, O_CVS = 19922944, O_SHS = 22020096, O_SRS = 26214400;
constexpr size_t SZ_WIN = (size_t)DIN * D * 2, SZ_WOUT = (size_t)D * D * 2, SZ_WGU = (size_t)2 * DFF * D * 2, SZ_WD = (size_t)D * DFF * 2;
constexpr size_t WS_WIN = 0, WS_WOUT = WS_WIN + SZ_WIN, WS_WGU = WS_WOUT + SZ_WOUT, WS_WD = WS_WGU + SZ_WGU;
constexpr size_t WS_X = WS_WD + SZ_WD;
constexpr size_t WS_ACT = WS_X + (size_t)MP * D * 4;
constexpr size_t WS_P = WS_ACT + (size_t)MP * D * 2;
constexpr size_t WS_INTRA = WS_P + (size_t)MP * DIN * 2;
constexpr size_t WS_QI = WS_INTRA + (size_t)MP * 1024 * 4;
constexpr int NITEM = 648;
constexpr size_t WS_LS = WS_QI + (size_t)MP * 1024 * 2;
constexpr size_t WS_DEC = WS_LS + (size_t)2 * NITEM * 16384 * 4;
constexpr size_t WS_CTL = WS_DEC + (size_t)NITEM * 128 * 4;
constexpr size_t CTL_BYTES = 196608;
constexpr size_t WS_RSF_OFF = 65536;
constexpr size_t WS_HB_OFF = 42467328;
constexpr size_t WS_WIN2 = WS_CTL + CTL_BYTES, WS_WOUT2 = WS_WIN2 + SZ_WIN, WS_WD2 = WS_WOUT2 + SZ_WOUT;
constexpr size_t WS_END = WS_WD2 + SZ_WD;

constexpr int LDS_BYTES = 147456;

struct Params;
struct Params {
    const float *x_prompt, *x_sample, *cache_k, *cache_v, *state_hgrn, *state_ret, *meta, *norm_mix, *norm_ffn, *w_in, *q_norm, *k_norm, *sinks, *hgrn_lb,
        *hgrn_norm, *ret_norm, *w_out, *w_gate, *w_up, *w_down;
    float* out; unsigned char* ws;
    int ph_lo, ph_hi, dummy, li;
};

__constant__ float INV_A[8] = {1.000000000e+00f, 1.939227432e-01f, 3.760603070e-02f, 7.292664610e-03f, 1.414213562e-03f, 2.742481884e-04f, 5.318295734e-05f, 1.031338525e-05f};
__constant__ float INV_C[64] = {1.000000000e+00f, 8.659643531e-01f, 7.498942018e-01f, 6.493816376e-01f, 5.623413324e-01f, 4.869675338e-01f, 4.216965139e-01f, 3.651741147e-01f, 3.162277639e-01f, 2.738419771e-01f, 2.371373773e-01f, 2.053525001e-01f, 1.778279394e-01f, 1.539926529e-01f, 1.333521456e-01f, 1.154781953e-01f, 1.000000015e-01f, 8.659642935e-02f, 7.498942316e-02f, 6.493816525e-02f, 5.623413250e-02f, 4.869675264e-02f, 4.216964915e-02f, 3.651741147e-02f, 3.162277490e-02f, 2.738419548e-02f, 2.371373773e-02f, 2.053525113e-02f, 1.778279431e-02f, 1.539926510e-02f, 1.333521400e-02f, 1.154781971e-02f, 9.999999776e-03f, 8.659643121e-03f, 7.498942316e-03f, 6.493816152e-03f, 5.623413250e-03f, 4.869675264e-03f, 4.216964822e-03f, 3.651741194e-03f, 3.162277630e-03f, 2.738419687e-03f, 2.371373819e-03f, 2.053525066e-03f, 1.778279431e-03f, 1.539926510e-03f, 1.333521446e-03f, 1.154782018e-03f, 1.000000047e-03f, 8.659643354e-04f, 7.498941850e-04f, 6.493816036e-04f, 5.623413017e-04f, 4.869675322e-04f, 4.216965172e-04f, 3.651741135e-04f, 3.162277571e-04f, 2.738419571e-04f, 2.371373703e-04f, 2.053525095e-04f, 1.778279402e-04f, 1.539926598e-04f, 1.333521504e-04f, 1.154782003e-04f};
__constant__ float LG[4] = {-3.174869716e-02f, -1.574835740e-02f, -7.843177766e-03f, -3.913899418e-03f};

typedef const Params __attribute__((address_space(4)))* KP;

__device__ __forceinline__ unsigned pk2(float lo, float hi);
__device__ __forceinline__ unsigned f2bf(float f) { return pk2(f, 0.f) & 0xffffu; }
typedef float f32x2_t __attribute__((ext_vector_type(2)));
typedef __bf16 bf16x2_t __attribute__((ext_vector_type(2)));
__device__ __forceinline__ unsigned pk2(float lo, float hi) { const f32x2_t v = {lo, hi}; const bf16x2_t b = __builtin_convertvector(v, bf16x2_t); return __builtin_bit_cast(unsigned, b); }
__device__ __forceinline__ unsigned f2bf_sw(float f) { unsigned u = __builtin_bit_cast(unsigned, f); return (u + 0x7fffu + ((u >> 16) & 1u)) >> 16; }
__device__ __forceinline__ unsigned pk2_sw(float lo, float hi) { return f2bf_sw(lo) | (f2bf_sw(hi) << 16); }
__device__ __forceinline__ float bf_lo(unsigned u) { return __builtin_bit_cast(float, u << 16); }
__device__ __forceinline__ float bf_hi(unsigned u) { return __builtin_bit_cast(float, u & 0xffff0000u); }
__device__ __forceinline__ float wave_sum(float v) {
#pragma unroll
    for (int o = 1; o < 64; o <<= 1) v += __shfl_xor(v, o);
    return v;
}
__device__ __forceinline__ float siluf(float x) { return x * __builtin_amdgcn_rcpf(1.f + __expf(-x)); }
__device__ __forceinline__ void sincos_red(float ang, float& s, float& c) {
    const float n = rintf(ang * 0.15915494309189535f);
    float r = fmaf(-n, 6.2831854820251465f, ang);
    r = fmaf(-n, -1.7484555e-7f, r);
    s = __sinf(r); c = __cosf(r);
}
#define LDS_WAIT() asm volatile("s_waitcnt lgkmcnt(0)" ::: "memory")

namespace pg8 {
constexpr int BM = 256, BK = 64, HALF = 128, HTB = HALF * BK * 2, NXCD = 8, WGM = 8;
__host__ __device__ __forceinline__ int lds_byte(int r, int c) { const int st = (r >> 4) * 2 + (c >> 5), rr = r & 15, cc = c & 31, ob = rr * 64 + cc * 2; return st * 1024 + (ob ^ (((ob >> 9) & 1) << 5)); }
__host__ __device__ __forceinline__ void stage_rc(int b, int& R, int& C) { const int st = b / 1024, sb = b % 1024, swz = sb ^ (((sb >> 9) & 1) << 5); R = (st >> 1) * 16 + swz / 64; C = (st & 1) * 32 + (swz % 64) / 2; }
struct Unit { int pm, pn, k0, nt; };
struct Gemm { const bf16_t* A; const bf16_t* Bt; int M, N, K; };
struct StaticOrder {
    int nM, nN, nwg, G, c, ntk, nExtra;
    __device__ __forceinline__ void init(int M, int N, int K, int G_, int c_, bool tail) { nM = M / BM; nN = N / BM; ntk = K / BK; G = G_; c = c_; nExtra = 0; if (tail) { nM -= 1; nExtra = nN * (ntk / 8); } nwg = nM * nN; }
    __device__ __forceinline__ bool next(int i, Unit& u) const {
        const long L = (long)i * G + c; const bool full = L < nwg; const int ei = full ? 0 : (int)(L - nwg);
        if (!full && ei >= nExtra) return false;
        int wgid = full ? (int)L : 0; { const int q = nwg / NXCD, r = nwg % NXCD, xcd = wgid % NXCD, off = wgid / NXCD; wgid = (xcd < r ? xcd * (q + 1) : r * (q + 1) + (xcd - r) * q) + off; }
        const int nig = WGM * nN, gid = wgid / nig, fm = gid * WGM, gsz = (nM - fm) < WGM ? (nM - fm) : WGM;
        const int pmf = fm + ((wgid % nig) % gsz), pnf = (wgid % nig) / gsz;
        u.pm = full ? pmf : nM; u.pn = full ? pnf : (ei % nN); u.k0 = full ? 0 : 8 * (ei / nN); u.nt = full ? ntk : 8; return true;
    }
};
struct EpiBf16 {
    bf16_t* O; int ldc;
    __device__ __forceinline__ void operator()(const f32x4 (&acc)[2][2][4][2], const Unit& u, int wr, int wc, int fr, int fq) const {
        const int row0 = u.pm * BM + wr * 64 + fr, col0 = u.pn * BM + wc * 32 + 8 * fq;
#pragma unroll
        for (int ai = 0; ai < 2; ++ai)
#pragma unroll
            for (int m = 0; m < 4; ++m) { bf16_t* rowp = O + (size_t)(row0 + ai * HALF + m * 16) * ldc + col0;
#pragma unroll
                for (int bj = 0; bj < 2; ++bj) { const f32x4 v0 = acc[ai][bj][m][0], v1 = acc[ai][bj][m][1]; u32x4 w; w.x = pk2(v0[0], v0[1]); w.y = pk2(v0[2], v0[3]); w.z = pk2(v1[0], v1[1]); w.w = pk2(v1[2], v1[3]);
                    *(u32x4*)(rowp + bj * HALF) = w; } }
    }
};
struct EpiResid {
    float* X; float* out; int ntk; float* part; const float* in_meta; const float* in_prompt; bf16_t* hb; const float* gvec; float* rs;
    __device__ __forceinline__ void operator()(const f32x4 (&acc)[2][2][4][2], const Unit& u, int wr, int wc, int fr, int fq) const {
        const int row0 = u.pm * BM + wr * 64 + fr, col0 = u.pn * BM + wc * 32 + 8 * fq;
        if (u.nt != ntk) {
            float* pb = part + (size_t)(u.k0 >> 3) * (160 * D);
#pragma unroll
            for (int ai = 0; ai < 2; ++ai)
#pragma unroll
                for (int m = 0; m < 4; ++m) { const int r = wr * 64 + fr + ai * HALF + m * 16; float* xr = pb + (size_t)r * D + col0;
                    if (r < 160) {
#pragma unroll
                        for (int bj = 0; bj < 2; ++bj)
#pragma unroll
                            for (int n = 0; n < 2; ++n) *(f32x4*)(xr + bj * HALF + n * 4) = acc[ai][bj][m][n]; } }
            return;
        }
        f32x4 gg[2][2];
        if (hb) {
#pragma unroll
            for (int bj = 0; bj < 2; ++bj)
#pragma unroll
                for (int n = 0; n < 2; ++n) gg[bj][n] = *(const f32x4*)(gvec + col0 + bj * HALF + n * 4); }
#pragma unroll
        for (int ai = 0; ai < 2; ++ai)
#pragma unroll
            for (int m = 0; m < 4; ++m) { const int row = row0 + ai * HALF + m * 16; float* xr = X + (size_t)row * D + col0; float* orow = nullptr; const float* src = xr; float ss = 0.f;
                const int b = row / LP, t = row - b * LP;
                if (out) { if (t >= 16) orow = out + O_YP + ((size_t)(b * 4096 + t - 16)) * D + col0; }
                if (in_prompt) src = (t < 16) ? in_meta + (size_t)t * D + col0 : in_prompt + ((size_t)(b * 4096 + t - 16)) * D + col0;
#pragma unroll
                for (int bj = 0; bj < 2; ++bj) { f32x4 v[2];
#pragma unroll
                    for (int n = 0; n < 2; ++n) { v[n] = *(const f32x4*)(src + bj * HALF + n * 4) + acc[ai][bj][m][n]; *(f32x4*)(xr + bj * HALF + n * 4) = v[n]; if (orow) *(f32x4*)(orow + bj * HALF + n * 4) = v[n]; }
                    if (hb) { ss += ((v[0][0] * v[0][0] + v[0][1] * v[0][1]) + (v[0][2] * v[0][2] + v[0][3] * v[0][3])) + ((v[1][0] * v[1][0] + v[1][1] * v[1][1]) + (v[1][2] * v[1][2] + v[1][3] * v[1][3]));
                        const f32x4 h0 = v[0] * gg[bj][0], h1 = v[1] * gg[bj][1]; u32x4 hw; hw.x = pk2(h0[0], h0[1]); hw.y = pk2(h0[2], h0[3]); hw.z = pk2(h1[0], h1[1]); hw.w = pk2(h1[2], h1[3]);
                        *(u32x4*)(hb + (size_t)row * D + col0 + bj * HALF) = hw; } }
                if (hb) { ss += __shfl_xor(ss, 16); ss += __shfl_xor(ss, 32); if (fq == 0) atomicAdd(rs + row, ss); } }
    }
};
struct EpiSwiglu {
    bf16_t* U; const float* rs;
    __device__ __forceinline__ void operator()(const f32x4 (&acc)[2][2][4][2], const Unit& u, int wr, int wc, int fr, int fq) const {
        const int row0 = u.pm * BM + wr * 64 + fr, col0 = u.pn * 128 + wc * 32 + 8 * fq;
#pragma unroll
        for (int ai = 0; ai < 2; ++ai)
#pragma unroll
            for (int m = 0; m < 4; ++m) { bf16_t* rowp = U + (size_t)(row0 + ai * HALF + m * 16) * DFF + col0;
                const float r = rsqrtf(rs[row0 + ai * HALF + m * 16] * (1.f / D) + EPS);
                const f32x4 g0 = acc[ai][0][m][0] * r, u0 = acc[ai][0][m][1] * r, g1 = acc[ai][1][m][0] * r, u1 = acc[ai][1][m][1] * r; u32x4 w;
                w.x = pk2(siluf(g0[0]) * u0[0], siluf(g0[1]) * u0[1]); w.y = pk2(siluf(g0[2]) * u0[2], siluf(g0[3]) * u0[3]);
                w.z = pk2(siluf(g1[0]) * u1[0], siluf(g1[1]) * u1[1]); w.w = pk2(siluf(g1[2]) * u1[2], siluf(g1[3]) * u1[3]);
                *(u32x4*)rowp = w; }
    }
};

template <class Epi>
__device__ __forceinline__ void gemm_phase(LAS unsigned char* lds, const Gemm g, const StaticOrder& S, const Epi& E, const int tid) {
    const int wid = __builtin_amdgcn_readfirstlane(tid >> 6), lane = tid & 63, wr = wid >> 2, wc = wid & 3, fr = lane & 15, fq = lane >> 4;
    const int K = g.K;
    unsigned voffA[2];
#pragma unroll
    for (int i = 0; i < 2; ++i) { int R, C; stage_rc(tid * 16 + i * 8192, R, C); voffA[i] = (unsigned)(R * K + C) * 2u; }
    const size_t kstep = (size_t)(BK * 2);
    const size_t hstep = (size_t)HALF * K * 2;
    const size_t tstep = 2 * hstep;
    const unsigned ldsw = (unsigned)wid * 1024u;
    const int aoff = lds_byte(wr * 64 + fr, fq * 8), boff = lds_byte(wc * 32 + fr, fq * 8);
#define PG8_SA(b, h) (((b) * 2 + (h)) * HTB)
#define PG8_SB(b, h) ((4 + (b) * 2 + (h)) * HTB)
#define PG8_STAGE(bufoff, gbase, voff) do { _Pragma("unroll") for (int _i = 0; _i < 2; ++_i) \
        __builtin_amdgcn_global_load_lds((const unsigned*)((const char*)(gbase) + (voff)[_i]), (LAS unsigned*)(lds + (bufoff) + ldsw + _i * 8192), 16, 0, 0); } while (0)
#define PG8_LDA(dst, b, h) do { _Pragma("unroll") for (int m = 0; m < 4; ++m) _Pragma("unroll") for (int k = 0; k < 2; ++k) dst[m][k] = *(const LAS bf16x8*)(lds + PG8_SA(b, h) + aoff + m * 2048 + k * 1024); } while (0)
#define PG8_LDB(dst, b, h) do { _Pragma("unroll") for (int n = 0; n < 2; ++n) _Pragma("unroll") for (int k = 0; k < 2; ++k) dst[n][k] = *(const LAS bf16x8*)(lds + PG8_SB(b, h) + boff + n * 2048 + k * 1024); } while (0)
#define PG8_MMA(ai, bj, At, Bt) do { __builtin_amdgcn_s_setprio(1); _Pragma("unroll") for (int m = 0; m < 4; ++m) _Pragma("unroll") for (int n = 0; n < 2; ++n) _Pragma("unroll") for (int k = 0; k < 2; ++k) \
        acc[ai][bj][m][n] = __builtin_amdgcn_mfma_f32_16x16x32_bf16(Bt[n][k], At[m][k], acc[ai][bj][m][n], 0, 0, 0); __builtin_amdgcn_s_setprio(0); } while (0)
#define PG8_WAIT_V(n) asm volatile("s_waitcnt vmcnt(" #n ")" ::: "memory")
#define PG8_WAIT_L(n) asm volatile("s_waitcnt lgkmcnt(" #n ")" ::: "memory")
#define PG8_BAR __builtin_amdgcn_s_barrier()
#define PG8_SCHED __builtin_amdgcn_sched_barrier(0)
    Unit cur, nxt; int ui = 0;
    if (!S.next(0, cur)) return;
    f32x4 acc[2][2][4][2];
#pragma unroll
    for (int a = 0; a < 2; ++a)
#pragma unroll
        for (int b = 0; b < 2; ++b)
#pragma unroll
            for (int m = 0; m < 4; ++m)
#pragma unroll
                for (int n = 0; n < 2; ++n) acc[a][b][m][n] = (f32x4){0.f, 0.f, 0.f, 0.f};
    bf16x8 At[4][2], B0[2][2], B1[2][2];
    const char* cA = (const char*)g.A + (size_t)cur.pm * tstep + (size_t)cur.k0 * kstep; const char* cB = (const char*)g.Bt + (size_t)cur.pn * tstep + (size_t)cur.k0 * kstep;
    PG8_STAGE(PG8_SB(0, 0), cB, voffA); PG8_STAGE(PG8_SB(0, 1), cB + hstep, voffA); PG8_STAGE(PG8_SA(0, 0), cA, voffA); PG8_STAGE(PG8_SA(0, 1), cA + hstep, voffA);
    if (wr == 1) PG8_BAR;
    PG8_WAIT_V(2); PG8_BAR;
    PG8_STAGE(PG8_SB(1, 0), cB + kstep, voffA); PG8_STAGE(PG8_SA(1, 0), cA + kstep, voffA); PG8_STAGE(PG8_SB(1, 1), cB + hstep + kstep, voffA);
    PG8_WAIT_V(6); PG8_BAR;
    for (;;) {
        const bool has_next = S.next(ui + 1, nxt);
        const char* nA = has_next ? (const char*)g.A + (size_t)nxt.pm * tstep + (size_t)nxt.k0 * kstep : cA; const char* nB = has_next ? (const char*)g.Bt + (size_t)nxt.pn * tstep + (size_t)nxt.k0 * kstep : cB;
        const int nt = cur.nt;
        for (int t = 0; t < nt; t += 2) {
            const bool last = (t == nt - 2);
            const char* a1 = cA + (size_t)(t + 1) * kstep;
            const char* a2 = last ? nA : cA + (size_t)(t + 2) * kstep; const char* b2 = last ? nB : cB + (size_t)(t + 2) * kstep;
            const char* a3 = a2 + kstep; const char* b3 = b2 + kstep;
            PG8_LDB(B0, 0, 0); PG8_LDB(B1, 0, 1); PG8_SCHED; PG8_LDA(At, 0, 0); PG8_STAGE(PG8_SA(1, 1), a1 + hstep, voffA);
            PG8_WAIT_V(8); PG8_WAIT_L(0); PG8_BAR; PG8_MMA(0, 0, At, B0); PG8_MMA(0, 1, At, B1); PG8_BAR; PG8_SCHED;
            PG8_LDA(At, 0, 1); PG8_STAGE(PG8_SB(0, 0), b2, voffA); PG8_STAGE(PG8_SB(0, 1), b2 + hstep, voffA); PG8_STAGE(PG8_SA(0, 0), a2, voffA);
            PG8_WAIT_V(8); PG8_WAIT_L(0); PG8_BAR; PG8_MMA(1, 0, At, B0); PG8_MMA(1, 1, At, B1); PG8_BAR; PG8_SCHED;
            PG8_LDB(B0, 1, 0); PG8_LDB(B1, 1, 1); PG8_SCHED; PG8_LDA(At, 1, 0); PG8_STAGE(PG8_SA(0, 1), a2 + hstep, voffA);
            PG8_WAIT_V(8); PG8_WAIT_L(0); PG8_BAR; PG8_MMA(0, 0, At, B0); PG8_MMA(0, 1, At, B1); PG8_BAR; PG8_SCHED;
            PG8_LDA(At, 1, 1); PG8_STAGE(PG8_SB(1, 0), b3, voffA); PG8_STAGE(PG8_SB(1, 1), b3 + hstep, voffA); PG8_STAGE(PG8_SA(1, 0), a3, voffA);
            PG8_WAIT_V(8); PG8_WAIT_L(0); PG8_BAR; PG8_MMA(1, 0, At, B0); PG8_MMA(1, 1, At, B1); PG8_BAR; PG8_SCHED;
        }
        if (wr == 0) PG8_BAR;
        E(acc, cur, wr, wc, fr, fq);
        if (!has_next) break;
#pragma unroll
        for (int a = 0; a < 2; ++a)
#pragma unroll
            for (int b = 0; b < 2; ++b)
#pragma unroll
                for (int m = 0; m < 4; ++m)
#pragma unroll
                    for (int n = 0; n < 2; ++n) acc[a][b][m][n] = (f32x4){0.f, 0.f, 0.f, 0.f};
        cur = nxt; cA = nA; cB = nB; ++ui;
        if (wr == 1) PG8_BAR;
    }
    PG8_WAIT_V(0);
    PG8_BAR;
#undef PG8_SA
#undef PG8_SB
#undef PG8_STAGE
#undef PG8_LDA
#undef PG8_LDB
#undef PG8_MMA
#undef PG8_WAIT_V
#undef PG8_WAIT_L
#undef PG8_BAR
#undef PG8_SCHED
}
}

__device__ __forceinline__ void transpose_item(const float* W, int K, int N, bf16_t* WT, int mode, LAS float* scr, int item, int lane) {
    const int nblk = N / 64, kb = item / nblk, nb = item - kb * nblk, k0 = 64 * kb, n0 = 64 * nb;
    const int lr = lane >> 4, lc = (lane & 15) * 4;
    f32x4 v[16];
#pragma unroll
    for (int i = 0; i < 16; ++i) v[i] = *(const f32x4*)(W + (size_t)(k0 + 4 * i + lr) * N + n0 + lc);
#pragma unroll
    for (int i = 0; i < 16; ++i) { LAS float* d = scr + (4 * i + lr) * 65 + lc; d[0] = v[i][0]; d[1] = v[i][1]; d[2] = v[i][2]; d[3] = v[i][3]; }
    LDS_WAIT();
    const int c = lane & 7;
#pragma unroll
    for (int j = 0; j < 8; ++j) { const int n = (lane >> 3) + 8 * j; const LAS float* s = scr + (8 * c) * 65 + n;
        u32x4 o; o.x = pk2(s[0 * 65], s[1 * 65]); o.y = pk2(s[2 * 65], s[3 * 65]); o.z = pk2(s[4 * 65], s[5 * 65]); o.w = pk2(s[6 * 65], s[7 * 65]);
        const int nn = n0 + n;
        const int orow = (mode == 0) ? nn
                       : (mode == 3) ? ((nn & ~31) + 16 * ((nn & 7) >> 2) + 4 * ((nn & 31) >> 3) + (nn & 3))
                       : (256 * (nn >> 7) + 128 * ((nn & 7) >> 2) + 32 * ((nn & 127) >> 5) + 16 * (mode - 1) + 4 * ((nn & 31) >> 3) + (nn & 3));
        *(u32x4*)(WT + (size_t)orow * K + k0 + 8 * c) = o; }
    LDS_WAIT();
}
__device__ __forceinline__ void norm_row(const float* xrow, const float* g, bf16_t* orow, float* xcopy, int lane, const float* part, int nparts, float* rs_out = nullptr) {
    f32x4 v[8]; float s = 0.f;
#pragma unroll
    for (int j = 0; j < 8; ++j) v[j] = xrow ? ((const f32x4*)xrow)[lane + 64 * j] : (f32x4){0.f, 0.f, 0.f, 0.f};
    for (int kp = 0; kp + 3 < nparts; kp += 4) {
        f32x4 t[4][8];
#pragma unroll
        for (int q = 0; q < 4; ++q)
#pragma unroll
            for (int j = 0; j < 8; ++j) t[q][j] = ((const f32x4*)(part + (size_t)(kp + q) * (160 * D)))[lane + 64 * j];
#pragma unroll
        for (int q = 0; q < 4; ++q)
#pragma unroll
            for (int j = 0; j < 8; ++j) v[j] = v[j] + t[q][j]; }
    for (int kp = nparts & ~3; kp < nparts; ++kp) {
#pragma unroll
        for (int j = 0; j < 8; ++j) v[j] = v[j] + ((const f32x4*)(part + (size_t)kp * (160 * D)))[lane + 64 * j]; }
#pragma unroll
    for (int j = 0; j < 8; ++j) s += (v[j][0] * v[j][0] + v[j][1] * v[j][1]) + (v[j][2] * v[j][2] + v[j][3] * v[j][3]);
    const float tot = wave_sum(s); const float r = rs_out ? 1.f : rsqrtf(tot * (1.f / D) + EPS);
    if (rs_out && lane == 0) *rs_out = tot;
#pragma unroll
    for (int j = 0; j < 8; ++j) { const f32x4 gg = ((const f32x4*)g)[lane + 64 * j]; u32x2 w; w.x = pk2(v[j][0] * r * gg[0], v[j][1] * r * gg[1]); w.y = pk2(v[j][2] * r * gg[2], v[j][3] * r * gg[3]);
        ((u32x2*)orow)[lane + 64 * j] = w; if (xcopy) ((f32x4*)xcopy)[lane + 64 * j] = v[j]; }
}

__device__ __forceinline__ void norm_row2(const float* x0, const float* x1, const float* g, bf16_t* o0, bf16_t* o1, float* c0, float* c1, int lane) {
    f32x4 a[8], b[8]; float s0 = 0.f, s1 = 0.f;
#pragma unroll
    for (int j = 0; j < 8; ++j) a[j] = x0 ? ((const f32x4*)x0)[lane + 64 * j] : (f32x4){0.f, 0.f, 0.f, 0.f};
#pragma unroll
    for (int j = 0; j < 8; ++j) b[j] = x1 ? ((const f32x4*)x1)[lane + 64 * j] : (f32x4){0.f, 0.f, 0.f, 0.f};
#pragma unroll
    for (int j = 0; j < 8; ++j) { s0 += (a[j][0] * a[j][0] + a[j][1] * a[j][1]) + (a[j][2] * a[j][2] + a[j][3] * a[j][3]); s1 += (b[j][0] * b[j][0] + b[j][1] * b[j][1]) + (b[j][2] * b[j][2] + b[j][3] * b[j][3]); }
    const float r0 = rsqrtf(wave_sum(s0) * (1.f / D) + EPS), r1 = rsqrtf(wave_sum(s1) * (1.f / D) + EPS);
#pragma unroll
    for (int j = 0; j < 8; ++j) { const f32x4 gg = ((const f32x4*)g)[lane + 64 * j]; u32x2 w;
        w.x = pk2(a[j][0] * r0 * gg[0], a[j][1] * r0 * gg[1]); w.y = pk2(a[j][2] * r0 * gg[2], a[j][3] * r0 * gg[3]); ((u32x2*)o0)[lane + 64 * j] = w; if (c0) ((f32x4*)c0)[lane + 64 * j] = a[j];
        w.x = pk2(b[j][0] * r1 * gg[0], b[j][1] * r1 * gg[1]); w.y = pk2(b[j][2] * r1 * gg[2], b[j][3] * r1 * gg[3]); ((u32x2*)o1)[lane + 64 * j] = w; if (c1) ((f32x4*)c1)[lane + 64 * j] = b[j]; }
}

__device__ __forceinline__ bf16x8 frag(const LAS bf16_t* base, int row0, int ld, int k0, int fr, int fq) { return *(const LAS bf16x8*)(base + (row0 + fr) * ld + k0 + fq * 8); }
typedef short v4i16_t __attribute__((ext_vector_type(4)));
__device__ __forceinline__ bf16x8 frag_tr(const LAS bf16_t* base, int ld, int k0, int n0, int lane) {
    const LAS bf16_t* a = base + (k0 + (lane >> 4) * 8 + ((lane >> 2) & 3)) * ld + n0 + 4 * (lane & 3);
    const v4i16_t lo = __builtin_amdgcn_ds_read_tr16_b64_v4i16((LAS v4i16_t*)a), hi = __builtin_amdgcn_ds_read_tr16_b64_v4i16((LAS v4i16_t*)(a + 4 * ld));
    return (bf16x8){lo[0], lo[1], lo[2], lo[3], hi[0], hi[1], hi[2], hi[3]};
}
#define MFMA16(a, b, c) __builtin_amdgcn_mfma_f32_16x16x32_bf16((a), (b), (c), 0, 0, 0)

__device__ __forceinline__ void attn_item(KP p, int l, int it, LAS unsigned char* lds, int tid) {
    const int lane = tid & 63, w = tid >> 6, fr = lane & 15, fq = lane >> 4;
    LAS bf16_t* Qs = (LAS bf16_t*)lds;
    LAS bf16_t* Ks = (LAS bf16_t*)(lds + 36864);
    LAS bf16_t* Vt = (LAS bf16_t*)(lds + 64512);
    LAS float* CS = (LAS float*)(lds + 92160);
    const bf16_t* P = (const bf16_t*)(p->ws + WS_P);
    bf16_t* MIX = (bf16_t*)(p->ws + WS_ACT);
    const bool samp = it >= 520;
    int b, hkv, q0pos, nq, rowq0;
    if (!samp) { b = it / 260; const int rem = it - b * 260; hkv = rem / 65; const int ch = rem - hkv * 65; q0pos = ch ? 16 + 64 * (ch - 1) : 0; nq = ch ? 64 : 16; rowq0 = b * LP + q0pos; }
    else { const int s = it - 520; b = s >> 2; hkv = s & 3; q0pos = PAST; nq = 4; rowq0 = NPROMPT + b * 4; }
    const int sub = tid & 15, r16 = tid >> 4;
    const f32x4 kn = *(const f32x4*)(p->k_norm + l * 64 + sub * 4), qn = *(const f32x4*)(p->q_norm + l * 64 + sub * 4);
    f32x4 kv[6], vv[6]; u32x2 qraw[8];
    if (!samp) {
#pragma unroll
        for (int ps = 0; ps < 6; ++ps) { const int pos = q0pos - 128 + ps * 32 + r16; const bf16_t* pr = P + (size_t)(b * LP + (pos < 0 ? 0 : pos)) * DIN + hkv * 64 + sub * 4;
            const u32x2 a = *(const u32x2*)(pr + C_KA), c = *(const u32x2*)(pr + C_VA);
            kv[ps] = (f32x4){bf_lo(a.x), bf_hi(a.x), bf_lo(a.y), bf_hi(a.y)}; vv[ps] = (f32x4){bf_lo(c.x), bf_hi(c.x), bf_lo(c.y), bf_hi(c.y)};
            if (pos < 0) { kv[ps] = (f32x4){0.f, 0.f, 0.f, 0.f}; vv[ps] = (f32x4){0.f, 0.f, 0.f, 0.f}; } }
    } else {
#pragma unroll
        for (int ps = 0; ps < 4; ++ps) { const int j = ps * 32 + r16; const size_t o = ((size_t)((l * 32 + b) * 128 + j)) * 256 + hkv * 64 + sub * 4; kv[ps] = *(const f32x4*)(p->cache_k + o); vv[ps] = *(const f32x4*)(p->cache_v + o); }
        { kv[4] = (f32x4){0.f, 0.f, 0.f, 0.f}; vv[4] = kv[4]; kv[5] = kv[4]; vv[5] = kv[4];
          if (r16 < 4) { const bf16_t* pr = P + (size_t)(NPROMPT + b * 4 + r16) * DIN + hkv * 64 + sub * 4; const u32x2 a = *(const u32x2*)(pr + C_KA), c = *(const u32x2*)(pr + C_VA);
              kv[4] = (f32x4){bf_lo(a.x), bf_hi(a.x), bf_lo(a.y), bf_hi(a.y)}; vv[4] = (f32x4){bf_lo(c.x), bf_hi(c.x), bf_lo(c.y), bf_hi(c.y)}; } }
    }
#pragma unroll
    for (int ps = 0; ps < 8; ++ps) { const int rowl = ps * 32 + r16, g = rowl >> 6, t = rowl & 63; qraw[ps] = (u32x2){0u, 0u};
        if (t < nq) qraw[ps] = *(const u32x2*)(P + (size_t)(rowq0 + t) * DIN + C_QA + (hkv * 4 + g) * 64 + sub * 4); }
#pragma unroll
    for (int r = 0; r < 3; ++r) { const int e = tid + r * 512; const int pos = q0pos - 128 + (e >> 3); float s, c; sincos_red((float)pos * INV_A[e & 7], s, c); CS[2 * e] = c; CS[2 * e + 1] = s; }
    __syncthreads();
#pragma unroll
    for (int ps = 0; ps < 6; ++ps) {
        const int j = ps * 32 + r16; const int pos = q0pos - 128 + j;
        const bool proc = samp ? (j >= 128 && j < 132) : (pos >= 0);
        f32x4 k4 = kv[ps]; const f32x4 v4 = vv[ps];
        float ss = (k4[0] * k4[0] + k4[1] * k4[1]) + (k4[2] * k4[2] + k4[3] * k4[3]);
        ss += __shfl_xor(ss, 1); ss += __shfl_xor(ss, 2); ss += __shfl_xor(ss, 4); ss += __shfl_xor(ss, 8);
        if (proc) { const float r = rsqrtf(ss * (1.f / 64.f) + EPS); k4 = k4 * r * kn; }
        f32x4 pt; pt[0] = __shfl_xor(k4[0], 2); pt[1] = __shfl_xor(k4[1], 2); pt[2] = __shfl_xor(k4[2], 2); pt[3] = __shfl_xor(k4[3], 2);
        { const LAS f32x4* cs = (const LAS f32x4*)(CS + (j * 8 + (sub & 1) * 4) * 2); const f32x4 c01 = cs[0], c23 = cs[1];
          const float cc[4] = {c01[0], c01[2], c23[0], c23[2]}, sn[4] = {c01[1], c01[3], c23[1], c23[3]};
          if (proc && sub < 4) {
#pragma unroll
              for (int e = 0; e < 4; ++e) k4[e] = (sub < 2) ? (k4[e] * cc[e] - pt[e] * sn[e]) : (k4[e] * cc[e] + pt[e] * sn[e]); } }
        u32x2 kw; kw.x = pk2(k4[0], k4[1]); kw.y = pk2(k4[2], k4[3]); *(LAS u32x2*)(Ks + j * 72 + sub * 4) = kw;
        { u32x2 vw; vw.x = pk2(v4[0], v4[1]); vw.y = pk2(v4[2], v4[3]); *(LAS u32x2*)(Vt + j * 72 + sub * 4) = vw; }
        if (!samp) { if (j >= 128 && pos >= LP - 128) { const size_t o = ((size_t)((l * 2 + b) * 128 + pos - (LP - 128))) * 256 + hkv * 64 + sub * 4; *(f32x4*)(p->out + O_CKP + o) = k4; *(f32x4*)(p->out + O_CVP + o) = v4; } }
        else if (j >= 4 && j < 132) { const size_t o = ((size_t)((l * 32 + b) * 128 + j - 4)) * 256 + hkv * 64 + sub * 4; *(f32x4*)(p->out + O_CKS + o) = k4; *(f32x4*)(p->out + O_CVS + o) = v4; }
    }
#pragma unroll
    for (int ps = 0; ps < 8; ++ps) {
        const int rowl = ps * 32 + r16, t = rowl & 63;
        f32x4 q4 = (f32x4){bf_lo(qraw[ps].x), bf_hi(qraw[ps].x), bf_lo(qraw[ps].y), bf_hi(qraw[ps].y)};
        float ss = (q4[0] * q4[0] + q4[1] * q4[1]) + (q4[2] * q4[2] + q4[3] * q4[3]);
        ss += __shfl_xor(ss, 1); ss += __shfl_xor(ss, 2); ss += __shfl_xor(ss, 4); ss += __shfl_xor(ss, 8);
        { const float r = rsqrtf(ss * (1.f / 64.f) + EPS); q4 = q4 * r * qn; }
        f32x4 pt; pt[0] = __shfl_xor(q4[0], 2); pt[1] = __shfl_xor(q4[1], 2); pt[2] = __shfl_xor(q4[2], 2); pt[3] = __shfl_xor(q4[3], 2);
        { const LAS f32x4* cs = (const LAS f32x4*)(CS + ((128 + t) * 8 + (sub & 1) * 4) * 2); const f32x4 c01 = cs[0], c23 = cs[1];
          const float cc[4] = {c01[0], c01[2], c23[0], c23[2]}, sn[4] = {c01[1], c01[3], c23[1], c23[3]};
          if (sub < 4) {
#pragma unroll
              for (int e = 0; e < 4; ++e) q4[e] = (sub < 2) ? (q4[e] * cc[e] - pt[e] * sn[e]) : (q4[e] * cc[e] + pt[e] * sn[e]); } }
        q4 = q4 * 0.125f;
        u32x2 qw; qw.x = pk2(q4[0], q4[1]); qw.y = pk2(q4[2], q4[3]); *(LAS u32x2*)(Qs + rowl * 72 + sub * 4) = qw;
    }
    __syncthreads();
    const int tb = (w & 1) * 32, g = w >> 1, hq = hkv * 4 + g;
    const float sk = p->sinks[l * 16 + hq];
    const int jlo = samp ? 0 : (128 - q0pos);
#pragma unroll 1
    for (int mt = 0; mt < 2; ++mt) {
        if (tb + mt * 16 >= nq) continue;
        const int rb = w * 32 + mt * 16;
        const bf16x8 qb0 = frag(Qs, rb, 72, 0, fr, fq), qb1 = frag(Qs, rb, 72, 32, fr, fq);
        f32x4 sacc[12];
        const int T0 = tb + mt * 16, n0 = T0 >> 4;
        const bool early = jlo > 0;
#pragma unroll
        for (int nt = 0; nt < 12; ++nt) { f32x4 z = {0.f, 0.f, 0.f, 0.f};
            if (nt >= n0 && nt <= n0 + 8) { z = MFMA16(frag(Ks, nt * 16, 72, 0, fr, fq), qb0, z); z = MFMA16(frag(Ks, nt * 16, 72, 32, fr, fq), qb1, z); }
            sacc[nt] = z; }
        const int t = T0 + fr; const int lo = (t + 1 > jlo) ? t + 1 : jlo; const unsigned span = (unsigned)(t + 128 - lo);
        float mx = -1e30f;
#pragma unroll
        for (int nt = 0; nt < 12; ++nt) { if (nt >= n0 && nt <= n0 + 8) {
#pragma unroll
                for (int i = 0; i < 4; ++i) { float sv = sacc[nt][i];
                    if (early || nt == n0 || nt == n0 + 8) { const int j = nt * 16 + 4 * fq + i; sv = ((unsigned)(j - lo) <= span) ? sv : -1e30f; sacc[nt][i] = sv; }
                    mx = fmaxf(mx, sv); } } }
        mx = fmaxf(mx, __shfl_xor(mx, 16)); mx = fmaxf(mx, __shfl_xor(mx, 32));
        mx = fmaxf(mx, sk); float sum = 0.f;
#pragma unroll
        for (int nt = 0; nt < 12; ++nt) { if (nt >= n0 && nt <= n0 + 8) {
#pragma unroll
                for (int i = 0; i < 4; ++i) { const float e = __expf(sacc[nt][i] - mx); sacc[nt][i] = e; sum += e; } } }
        sum += __shfl_xor(sum, 16); sum += __shfl_xor(sum, 32);
        const float inv = __builtin_amdgcn_rcpf(sum + __expf(sk - mx));
        f32x4 oacc[4];
#pragma unroll
        for (int dt = 0; dt < 4; ++dt) oacc[dt] = (f32x4){0.f, 0.f, 0.f, 0.f};
#pragma unroll
        for (int m = 0; m < 6; ++m) {
            if (2 * m + 1 >= n0 && 2 * m <= n0 + 8) {
                const f32x4 pa = sacc[2 * m] * inv, pc = sacc[2 * m + 1] * inv;
                const u32x4 pw = {pk2(pa[0], pa[1]), pk2(pa[2], pa[3]), pk2(pc[0], pc[1]), pk2(pc[2], pc[3])};
                const bf16x8 pb = __builtin_bit_cast(bf16x8, pw);
                const LAS bf16_t* va = Vt + (32 * m + fq * 4 + ((lane >> 2) & 3)) * 72 + 8 * (lane & 3);
#pragma unroll
                for (int dt = 0; dt < 4; ++dt) { const int co = 32 * (dt >> 1) + 4 * (dt & 1); const v4i16_t vl = __builtin_amdgcn_ds_read_tr16_b64_v4i16((LAS v4i16_t*)(va + co)), vh = __builtin_amdgcn_ds_read_tr16_b64_v4i16((LAS v4i16_t*)(va + 16 * 72 + co));
                    oacc[dt] = MFMA16(((bf16x8){vl[0], vl[1], vl[2], vl[3], vh[0], vh[1], vh[2], vh[3]}), pb, oacc[dt]); } } }
        if (t < nq) {
#pragma unroll
            for (int e = 0; e < 2; ++e) { const f32x4 o0 = oacc[2 * e], o1 = oacc[2 * e + 1]; u32x4 ow; ow.x = pk2(o0[0], o0[1]); ow.y = pk2(o0[2], o0[3]); ow.z = pk2(o1[0], o1[1]); ow.w = pk2(o1[2], o1[3]);
                *(u32x4*)(MIX + (size_t)(rowq0 + t) * D + hq * 64 + 32 * e + 8 * fq) = ow; } }
    }
    __syncthreads();
}

__device__ __forceinline__ void chunk_item(KP p, int l, int mx, int it, LAS unsigned char* lds, int tid) {
    const int lane = tid & 63, w = tid >> 6, fr = lane & 15, fq = lane >> 4;
    LAS float* G = (LAS float*)lds;
    LAS bf16_t* Qt = (LAS bf16_t*)(lds + 32768);
    LAS bf16_t* Kt = (LAS bf16_t*)(lds + 50176);
    LAS bf16_t* Vt = (LAS bf16_t*)(lds + 67584);
    LAS bf16_t* Kst = (LAS bf16_t*)(lds + 86016);
    LAS bf16_t* As = (LAS bf16_t*)(lds + 104448);
    LAS float* TOT = (LAS float*)(lds + 113664);
    const bf16_t* P = (const bf16_t*)(p->ws + WS_P);
    float* INTRA = (float*)(p->ws + WS_INTRA); bf16_t* QI = (bf16_t*)(p->ws + WS_QI); float* LS = (float*)(p->ws + WS_LS); float* DEC = (float*)(p->ws + WS_DEC);
    const bool samp = it >= 520;
    int h, nq, rowbase, pos0;
    if (!samp) { const int seq = it / 65, c = it - seq * 65; const int b = seq >> 2; h = seq & 3; const int q0 = c ? 16 + 64 * (c - 1) : 0; nq = c ? 64 : 16; rowbase = b * LP + q0; pos0 = q0; }
    else { const int s = it - 520; const int b = s >> 2; h = s & 3; nq = 4; rowbase = NPROMPT + b * 4; pos0 = PAST; }
    const int c4 = (tid & 31) * 4, tr = tid >> 5;
    const float lgh = LG[h];
    if (mx == 0) {
        u32x2 rf[4], rq[4], ri[4];
#pragma unroll
        for (int ps = 0; ps < 4; ++ps) { const int t = ps * 16 + tr; rf[ps] = (u32x2){0u, 0u}; rq[ps] = rf[ps]; ri[ps] = rf[ps];
            if (t < nq) { const bf16_t* pr = P + (size_t)(rowbase + t) * DIN + h * 128 + c4; rf[ps] = *(const u32x2*)(pr + C_FB); rq[ps] = *(const u32x2*)(pr + C_QB); ri[ps] = *(const u32x2*)(pr + C_IB); } }
        float lbv[4];
#pragma unroll
        for (int e = 0; e < 4; ++e) { float v = 0.f; if (l == 1) { const float a0 = p->hgrn_lb[h * 128 + c4 + e], a1 = p->hgrn_lb[512 + h * 128 + c4 + e]; v = 1.f / (1.f + expf(a0 - a1)); } lbv[e] = v; }
        f32x4 lf[4], kk[4];
#pragma unroll
        for (int ps = 0; ps < 4; ++ps) { const int t = ps * 16 + tr; lf[ps] = (f32x4){0.f, 0.f, 0.f, 0.f}; kk[ps] = lf[ps];
            if (t < nq) { const float z[4] = {bf_lo(rf[ps].x), bf_hi(rf[ps].x), bf_lo(rf[ps].y), bf_hi(rf[ps].y)};
#pragma unroll
                for (int e = 0; e < 4; ++e) { const float ez = __expf(-fabsf(z[e])), rc = __builtin_amdgcn_rcpf(1.f + ez); const float sp = (z[e] >= 0.f) ? rc : ez * rc, sm = (z[e] >= 0.f) ? ez * rc : rc;
                    const float om = 1.f - lbv[e]; lf[ps][e] = __logf(fmaxf(lbv[e], 1e-30f) + om * sp); kk[ps][e] = om * sm; } }
            *(LAS f32x4*)(G + t * 128 + c4) = lf[ps]; }
        __syncthreads();
        { const int seg = tid >> 7, k = tid & 127; float r[16]; float run = 0.f;
#pragma unroll
          for (int i = 0; i < 16; ++i) { run += G[(seg * 16 + i) * 128 + k]; r[i] = run; }
          TOT[seg * 128 + k] = run;
          __syncthreads();
          float off = 0.f;
#pragma unroll
          for (int s2 = 0; s2 < 3; ++s2) off += (s2 < seg) ? TOT[s2 * 128 + k] : 0.f;
#pragma unroll
          for (int i = 0; i < 16; ++i) G[(seg * 16 + i) * 128 + k] = r[i] + off; }
        __syncthreads();
        const f32x4 gm = *(const LAS f32x4*)(G + 31 * 128 + c4), gl = *(const LAS f32x4*)(G + 63 * 128 + c4);
        const f32x4 egm = {__expf(gm[0]), __expf(gm[1]), __expf(gm[2]), __expf(gm[3])}, eglm = {__expf(gl[0] - gm[0]), __expf(gl[1] - gm[1]), __expf(gl[2] - gm[2]), __expf(gl[3] - gm[3])};
#pragma unroll
        for (int ps = 0; ps < 4; ++ps) { const int t = ps * 16 + tr; const bool valid = t < nq;
            const float zq[4] = {bf_lo(rq[ps].x), bf_hi(rq[ps].x), bf_lo(rq[ps].y), bf_hi(rq[ps].y)}; const u32x2 iv = ri[ps];
            const f32x4 gg = *(const LAS f32x4*)(G + t * 128 + c4);
            float qt[4], kt[4], qi[4], ks4[4];
#pragma unroll
            for (int e = 0; e < 4; ++e) { const float kv = kk[ps][e]; const float q = valid ? siluf(zq[e]) : 0.f;
                const float dg = fminf(fmaxf(gg[e] - gm[e], -80.f), 80.f); const float ep = __expf(dg), en = __builtin_amdgcn_rcpf(ep);
                qt[e] = q * ep; kt[e] = kv * en; qi[e] = qt[e] * egm[e];
                ks4[e] = kt[e] * eglm[e]; }
            u32x2 w2; w2.x = pk2(qt[0], qt[1]); w2.y = pk2(qt[2], qt[3]); *(LAS u32x2*)(Qt + t * 136 + c4) = w2;
            w2.x = pk2(kt[0], kt[1]); w2.y = pk2(kt[2], kt[3]); *(LAS u32x2*)(Kt + t * 136 + c4) = w2;
            w2.x = pk2(ks4[0], ks4[1]); w2.y = pk2(ks4[2], ks4[3]); *(LAS u32x2*)(Kst + t * 136 + c4) = w2;
            *(LAS u32x2*)(Vt + t * 136 + c4) = iv;
            if (valid) { w2.x = pk2(qi[0], qi[1]); w2.y = pk2(qi[2], qi[3]); *(u32x2*)(QI + (size_t)(rowbase + t) * 1024 + h * 128 + c4) = w2; }
            if (t == 63) *(f32x4*)(DEC + (size_t)it * 128 + c4) = (f32x4){__expf(gl[0]), __expf(gl[1]), __expf(gl[2]), __expf(gl[3])}; }
    } else {
        const int i2 = (tid & 31) * 2;
        unsigned ra[4], rb[4], rc[4], rd[4]; u32x2 ri[4];
#pragma unroll
        for (int ps = 0; ps < 4; ++ps) { const int t = ps * 16 + tr; ra[ps] = 0u; rb[ps] = 0u; rc[ps] = 0u; rd[ps] = 0u; ri[ps] = (u32x2){0u, 0u};
            if (t < nq) { const bf16_t* pr = P + (size_t)(rowbase + t) * DIN + h * 128; ra[ps] = *(const unsigned*)(pr + C_QC + i2); rb[ps] = *(const unsigned*)(pr + C_QC + 64 + i2); rc[ps] = *(const unsigned*)(pr + C_KC + i2); rd[ps] = *(const unsigned*)(pr + C_KC + 64 + i2);
                ri[ps] = *(const u32x2*)(pr + C_VC + c4); } }
#pragma unroll
        for (int ps = 0; ps < 4; ++ps) { const int t = ps * 16 + tr; const bool valid = t < nq;
            const float q1[2] = {bf_lo(ra[ps]), bf_hi(ra[ps])}, q2[2] = {bf_lo(rb[ps]), bf_hi(rb[ps])}, k1[2] = {bf_lo(rc[ps]), bf_hi(rc[ps])}, k2[2] = {bf_lo(rd[ps]), bf_hi(rd[ps])}; const u32x2 iv = ri[ps];
            const float tail = valid ? __expf(lgh * (float)(nq - 1 - t)) : 0.f;
            float qa[2], qb[2], ka[2], kb[2];
#pragma unroll
            for (int e = 0; e < 2; ++e) { float s, c; sincos_red((float)(pos0 + t) * INV_C[i2 + e], s, c);
                qa[e] = q1[e] * c - q2[e] * s; qb[e] = q2[e] * c + q1[e] * s; ka[e] = (k1[e] * c - k2[e] * s) * 0.08838834764831845f; kb[e] = (k2[e] * c + k1[e] * s) * 0.08838834764831845f;
                }
            const unsigned qlo = pk2(qa[0], qa[1]), qhi = pk2(qb[0], qb[1]);
            *(LAS unsigned*)(Qt + t * 136 + i2) = qlo; *(LAS unsigned*)(Qt + t * 136 + 64 + i2) = qhi;
            *(LAS unsigned*)(Kt + t * 136 + i2) = pk2(ka[0], ka[1]); *(LAS unsigned*)(Kt + t * 136 + 64 + i2) = pk2(kb[0], kb[1]);
            *(LAS unsigned*)(Kst + t * 136 + i2) = pk2(ka[0] * tail, ka[1] * tail); *(LAS unsigned*)(Kst + t * 136 + 64 + i2) = pk2(kb[0] * tail, kb[1] * tail);
            *(LAS u32x2*)(Vt + t * 136 + c4) = iv;
            if (valid) { bf16_t* qr = QI + (size_t)(rowbase + t) * 1024 + 512 + h * 128; *(unsigned*)(qr + i2) = qlo; *(unsigned*)(qr + 64 + i2) = qhi; } }
    }
    __syncthreads();
    const int colo = mx * 512 + h * 128;
    if ((w >> 1) * 16 < nq) { const int qt = w >> 1, vh = w & 1, q = qt * 16 + fr;
      f32x4 at[4];
#pragma unroll
      for (int st = 0; st < 4; ++st) { f32x4 z = {0.f, 0.f, 0.f, 0.f};
          if (st <= qt) {
#pragma unroll
              for (int ks = 0; ks < 4; ++ks) z = MFMA16(frag(Kt, st * 16, 136, ks * 32, fr, fq), frag(Qt, qt * 16, 136, ks * 32, fr, fq), z);
#pragma unroll
              for (int i = 0; i < 4; ++i) { const int sI = st * 16 + 4 * fq + i; float v = (sI <= q) ? z[i] : 0.f; if (mx == 1) v *= __expf(lgh * (float)((sI <= q) ? (q - sI) : 0)); z[i] = v; } }
          at[st] = z; }
#pragma unroll
      for (int e = 0; e < 2; ++e) { const int vp = vh * 2 + e; f32x4 acc0 = {0.f, 0.f, 0.f, 0.f}, acc1 = {0.f, 0.f, 0.f, 0.f};
#pragma unroll
          for (int m = 0; m < 2; ++m) { if (2 * m <= qt) {
                  const u32x4 pw = {pk2(at[2 * m][0], at[2 * m][1]), pk2(at[2 * m][2], at[2 * m][3]), pk2(at[2 * m + 1][0], at[2 * m + 1][1]), pk2(at[2 * m + 1][2], at[2 * m + 1][3])};
                  const bf16x8 pb = __builtin_bit_cast(bf16x8, pw);
                  const LAS bf16_t* va = Vt + (32 * m + fq * 4 + ((lane >> 2) & 3)) * 136 + 32 * vp + 8 * (lane & 3);
                  const v4i16_t l0 = __builtin_amdgcn_ds_read_tr16_b64_v4i16((LAS v4i16_t*)va), h0 = __builtin_amdgcn_ds_read_tr16_b64_v4i16((LAS v4i16_t*)(va + 16 * 136));
                  const v4i16_t l1 = __builtin_amdgcn_ds_read_tr16_b64_v4i16((LAS v4i16_t*)(va + 4)), h1 = __builtin_amdgcn_ds_read_tr16_b64_v4i16((LAS v4i16_t*)(va + 16 * 136 + 4));
                  acc0 = MFMA16(((bf16x8){l0[0], l0[1], l0[2], l0[3], h0[0], h0[1], h0[2], h0[3]}), pb, acc0);
                  acc1 = MFMA16(((bf16x8){l1[0], l1[1], l1[2], l1[3], h1[0], h1[1], h1[2], h1[3]}), pb, acc1); } }
          if (q < nq) { u32x4 iw; iw.x = pk2(acc0[0], acc0[1]); iw.y = pk2(acc0[2], acc0[3]); iw.z = pk2(acc1[0], acc1[1]); iw.w = pk2(acc1[2], acc1[3]);
              *(u32x4*)((bf16_t*)INTRA + (size_t)(rowbase + q) * 1024 + colo + 32 * vp + 8 * fq) = iw; } } }
    bf16_t* ls = (bf16_t*)LS + ((size_t)mx * NITEM + it) * 16384;
#pragma unroll
    for (int vp = 0; vp < 4; ++vp) { f32x4 acc0 = {0.f, 0.f, 0.f, 0.f}, acc1 = {0.f, 0.f, 0.f, 0.f};
#pragma unroll
        for (int ks = 0; ks < 2; ++ks) { const bf16x8 kf = frag_tr(Kst, 136, ks * 32, w * 16, lane);
            const LAS bf16_t* va = Vt + (ks * 32 + (lane >> 4) * 8 + ((lane >> 2) & 3)) * 136 + 32 * vp + 8 * (lane & 3);
            const v4i16_t l0 = __builtin_amdgcn_ds_read_tr16_b64_v4i16((LAS v4i16_t*)va), h0 = __builtin_amdgcn_ds_read_tr16_b64_v4i16((LAS v4i16_t*)(va + 4 * 136));
            const v4i16_t l1 = __builtin_amdgcn_ds_read_tr16_b64_v4i16((LAS v4i16_t*)(va + 4)), h1 = __builtin_amdgcn_ds_read_tr16_b64_v4i16((LAS v4i16_t*)(va + 4 * 136 + 4));
            acc0 = MFMA16(((bf16x8){l0[0], l0[1], l0[2], l0[3], h0[0], h0[1], h0[2], h0[3]}), kf, acc0);
            acc1 = MFMA16(((bf16x8){l1[0], l1[1], l1[2], l1[3], h1[0], h1[1], h1[2], h1[3]}), kf, acc1); }
        u32x4 lw; lw.x = pk2(acc0[0], acc0[1]); lw.y = pk2(acc0[2], acc0[3]); lw.z = pk2(acc1[0], acc1[1]); lw.w = pk2(acc1[2], acc1[3]);
        *(u32x4*)(ls + (w * 16 + fr) * 128 + 32 * vp + 8 * fq) = lw; }
    __syncthreads();
}

__device__ __forceinline__ void finish_item(KP p, int l, int mx, int it, LAS unsigned char* lds, int tid) {
    const int lane = tid & 63, w = tid >> 6, fr = lane & 15, fq = lane >> 4;
    LAS bf16_t* St = (LAS bf16_t*)lds;
    LAS bf16_t* Qi = (LAS bf16_t*)(lds + 34816);
    LAS float* Ob = (LAS float*)(lds + 52224);
    const bf16_t* P = (const bf16_t*)(p->ws + WS_P);
    const float* INTRA = (const float*)(p->ws + WS_INTRA); const bf16_t* QI = (const bf16_t*)(p->ws + WS_QI); const float* LS = (const float*)(p->ws + WS_LS);
    bf16_t* MIX = (bf16_t*)(p->ws + WS_ACT);
    const bool samp = it >= 520;
    int h, nq, rowbase; const float* S = nullptr; const bf16_t* Sb = nullptr;
    if (!samp) { const int seq = it / 65, c = it - seq * 65; const int b = seq >> 2; h = seq & 3; const int q0 = c ? 16 + 64 * (c - 1) : 0; nq = c ? 64 : 16; rowbase = b * LP + q0;
        if (c) Sb = (const bf16_t*)LS + ((size_t)mx * NITEM + it - 1) * 16384; }
    else { const int s = it - 520; const int b = s >> 2; h = s & 3; nq = 4; rowbase = NPROMPT + b * 4; S = (mx ? p->state_ret : p->state_hgrn) + ((size_t)((l * 32 + b) * 4 + h)) * 16384; }
    const int colo = mx * 512 + h * 128;
    const int v4 = (tid & 31) * 4, kr = tid >> 5;
    u32x2 sw[8]; u32x4 qv[2]; f32x4 iv[4]; u32x4 g0 = {0u, 0u, 0u, 0u}, g1 = {0u, 0u, 0u, 0u};
#pragma unroll
    for (int ps = 0; ps < 8; ++ps) { sw[ps] = (u32x2){0u, 0u};
        if (Sb) sw[ps] = *(const u32x2*)(Sb + (ps * 16 + kr) * 128 + v4);
        else if (S) { const f32x4 f = *(const f32x4*)(S + (ps * 16 + kr) * 128 + v4); sw[ps].x = pk2(f[0], f[1]); sw[ps].y = pk2(f[2], f[3]); } }
#pragma unroll
    for (int r = 0; r < 2; ++r) { const int idx = tid + r * 512, t = idx >> 4, ch = idx & 15; qv[r] = (u32x4){0u, 0u, 0u, 0u}; if (t < nq) qv[r] = *(const u32x4*)(QI + (size_t)(rowbase + t) * 1024 + colo + ch * 8); }
#pragma unroll
    for (int tt = 0; tt < 4; ++tt) { const int t = tt * 16 + fr; iv[tt] = (f32x4){0.f, 0.f, 0.f, 0.f}; if (t < nq) { const u32x2 u = *(const u32x2*)((const bf16_t*)INTRA + (size_t)(rowbase + t) * 1024 + colo + w * 16 + 4 * fq); iv[tt] = (f32x4){bf_lo(u.x), bf_hi(u.x), bf_lo(u.y), bf_hi(u.y)}; } }
    const int t8 = tid >> 3, part = tid & 7;
    if (t8 < nq) { const bf16_t* gp = P + (size_t)(rowbase + t8) * DIN + (mx ? C_GC : C_GB) + h * 128 + part * 16; g0 = *(const u32x4*)gp; g1 = *(const u32x4*)(gp + 8); }
#pragma unroll
    for (int ps = 0; ps < 8; ++ps) { const int k = ps * 16 + kr; *(LAS u32x2*)(St + k * 136 + v4) = sw[ps]; }
#pragma unroll
    for (int r = 0; r < 2; ++r) { const int idx = tid + r * 512, t = idx >> 4, ch = idx & 15; *(LAS u32x4*)(Qi + t * 136 + ch * 8) = qv[r]; }
    __syncthreads();
    const float lgh = LG[h];
#pragma unroll
    for (int tt = 0; tt < 4; ++tt) { f32x4 acc = {0.f, 0.f, 0.f, 0.f};
#pragma unroll
        for (int ks = 0; ks < 4; ++ks) acc = MFMA16(frag_tr(St, 136, ks * 32, w * 16, lane), frag(Qi, tt * 16, 136, ks * 32, fr, fq), acc);
        const int t = tt * 16 + fr;
        if (mx == 1) acc = acc * __expf(lgh * (float)(t + 1));
        acc = acc + iv[tt];
        *(LAS f32x4*)(Ob + t * 132 + w * 16 + 4 * fq) = acc; }
    __syncthreads();
    { const int t = t8; const LAS float* orow = Ob + t * 132 + part * 16; float o[16]; float ss = 0.f;
#pragma unroll
      for (int j = 0; j < 4; ++j) { const f32x4 v = *(const LAS f32x4*)(orow + 4 * j); o[4 * j] = v[0]; o[4 * j + 1] = v[1]; o[4 * j + 2] = v[2]; o[4 * j + 3] = v[3]; ss += (v[0] * v[0] + v[1] * v[1]) + (v[2] * v[2] + v[3] * v[3]); }
      ss += __shfl_xor(ss, 1); ss += __shfl_xor(ss, 2); ss += __shfl_xor(ss, 4);
      if (t < nq) { const float r = rsqrtf(ss * (1.f / 128.f) + EPS); const float* nw = (mx ? p->ret_norm : p->hgrn_norm) + l * 128 + part * 16;
          const unsigned gw[8] = {g0.x, g0.y, g0.z, g0.w, g1.x, g1.y, g1.z, g1.w}; unsigned ow[8];
#pragma unroll
          for (int j = 0; j < 8; ++j) { const float a = o[2 * j] * r * nw[2 * j] * siluf(bf_lo(gw[j])), b2 = o[2 * j + 1] * r * nw[2 * j + 1] * siluf(bf_hi(gw[j])); ow[j] = pk2(a, b2); }
          bf16_t* mp = MIX + (size_t)(rowbase + t) * D + 1024 + colo + part * 16;
          *(u32x4*)mp = (u32x4){ow[0], ow[1], ow[2], ow[3]}; *(u32x4*)(mp + 8) = (u32x4){ow[4], ow[5], ow[6], ow[7]}; } }
    __syncthreads();
}

__device__ __forceinline__ void scan_phase(KP p, int l, int tid) {
    bf16_t* LS = (bf16_t*)(p->ws + WS_LS); const float* DEC = (const float*)(p->ws + WS_DEC);
#define LDB4(ptr) ({ const u32x2 _u = *(const u32x2*)(ptr); (f32x4){bf_lo(_u.x), bf_hi(_u.x), bf_lo(_u.y), bf_hi(_u.y)}; })
    const int gid = blockIdx.x * 512 + tid, gsz = gridDim.x * 512;
    for (int idx = gid; idx < 131072; idx += gsz) { const int mx = idx >> 16, seq = (idx >> 13) & 7, e2 = idx & 8191, k = e2 >> 6, h = seq & 3, b = seq >> 2;
        float s0 = 0.f, s1 = 0.f; bf16_t* base = LS + ((size_t)mx * NITEM + seq * 65) * 16384 + e2 * 2; const float* dp = DEC + (size_t)(seq * 65) * 128 + k;
        const float d16 = __expf(LG[h] * 16.f), d64 = __expf(LG[h] * 64.f);
        unsigned ls[13], ln[13]; float dd[13], dn[13];
#pragma unroll
        for (int j = 0; j < 13; ++j) { ls[j] = *(const unsigned*)(base + (size_t)j * 16384); dd[j] = mx ? (j ? d64 : d16) : dp[j * 128]; }
#pragma unroll 1
        for (int g5 = 0; g5 < 5; ++g5) {
            if (g5 < 4) {
#pragma unroll
                for (int j = 0; j < 13; ++j) { const int c = (g5 + 1) * 13 + j; ln[j] = *(const unsigned*)(base + (size_t)c * 16384); dn[j] = mx ? d64 : dp[c * 128]; } }
#pragma unroll
            for (int j = 0; j < 13; ++j) { const int c = g5 * 13 + j; s0 = s0 * dd[j] + bf_lo(ls[j]); s1 = s1 * dd[j] + bf_hi(ls[j]); *(unsigned*)(base + (size_t)c * 16384) = pk2(s0, s1); }
#pragma unroll
            for (int j = 0; j < 13; ++j) { ls[j] = ln[j]; dd[j] = dn[j]; }
        }
        float* o = p->out + (mx ? O_SRP : O_SHP) + ((size_t)((l * 2 + b) * 4 + h)) * 16384 + e2 * 2; o[0] = s0; o[1] = s1; }
    for (int idx = gid; idx < 2 * 128 * 4096; idx += gsz) { const int mx = idx >> 19, s_ = (idx >> 12) & 127, e4 = idx & 4095, k = e4 >> 5, b = s_ >> 2, h = s_ & 3, it = 520 + s_;
        const size_t so = ((size_t)((l * 32 + b) * 4 + h)) * 16384 + e4 * 4;
        const f32x4 s0 = *(const f32x4*)((mx ? p->state_ret : p->state_hgrn) + so); const f32x4 ls = LDB4(LS + ((size_t)mx * NITEM + it) * 16384 + e4 * 4);
        const float d = mx ? __expf(LG[h] * 4.f) : DEC[(size_t)it * 128 + k];
        *(f32x4*)(p->out + (mx ? O_SRS : O_SHS) + so) = s0 * d + ls; }
#undef LDB4
}

#define XB_TMO      128
#define XB_XCNT(j)  (256  + 64 * (j))
#define XB_XSUB(j)  (1280 + 64 * (j))
#define XB_XGEN(j)  (2304 + 64 * (j))
#define XB_TOP      3328
#define XB_TOPGEN   3392
#define XCD_BAR_WORDS 3456
#define XB_SPIN_CAP (1u << 18)
__device__ __forceinline__ unsigned xb_ld(unsigned* p)              { return __hip_atomic_load(p, __ATOMIC_RELAXED, __HIP_MEMORY_SCOPE_AGENT); }
__device__ __forceinline__ unsigned xb_add(unsigned* p, unsigned v) { return __hip_atomic_fetch_add(p, v, __ATOMIC_RELAXED, __HIP_MEMORY_SCOPE_AGENT); }
__device__ __forceinline__ unsigned xb_xcc_id() { return (unsigned)__builtin_amdgcn_s_getreg((3 << 11) | 20) & 0xFu; }
#define XB_SPIN(cond, bar) do { unsigned _sp = 0; while (cond) { __builtin_amdgcn_s_sleep(1); \
    if ((++_sp & 255u) == 0u) { if (xb_ld(&(bar)[XB_TMO])) break; if (_sp > XB_SPIN_CAP) { atomicAdd(&(bar)[XB_TMO], 1u); break; } } } } while (0)
struct XcdBarrier { unsigned* bar; unsigned x; volatile LAS unsigned* st; };
__device__ __forceinline__ XcdBarrier xcd_barrier_post(unsigned* bar, volatile LAS unsigned* st) {
    XcdBarrier b; b.bar = bar; b.x = xb_xcc_id(); b.st = st;
    if (threadIdx.x == 0) (void)xb_add(&bar[XB_XCNT(b.x)], 1u);
    return b;
}
__device__ __forceinline__ void xcd_barrier_complete(unsigned* bar, unsigned x, unsigned& nloc, unsigned& nx) {
    const unsigned G = gridDim.x * gridDim.y * gridDim.z;
    unsigned sum, cnt, mine, sp = 0u;
    for (;;) {
        sum = 0u; cnt = 0u; mine = 0u;
#pragma unroll
        for (unsigned j = 0; j < 16; ++j) { const unsigned c = xb_ld(&bar[XB_XCNT(j)]); sum += c; cnt += (c > 0u) ? 1u : 0u; mine = (j == x) ? c : mine; }
        if (sum == G) break;
        __builtin_amdgcn_s_sleep(1);
        if ((++sp & 255u) == 0u) { if (xb_ld(&bar[XB_TMO])) break; if (sp > XB_SPIN_CAP) { atomicAdd(&bar[XB_TMO], 1u); break; } }
    }
    nloc = mine > 0u ? mine : 1u; nx = cnt > 0u ? cnt : 1u;
}
__device__ __forceinline__ void xcd_barrier(const XcdBarrier& b, const int tid) {
    asm volatile("s_waitcnt vmcnt(0)" ::: "memory");
    __syncthreads();
    if (tid == 0) {
        unsigned* bar = b.bar;
        __builtin_amdgcn_s_waitcnt(0);
        unsigned nloc = b.st[0], nx = b.st[1];
        if (nloc == 0u) { xcd_barrier_complete(bar, b.x, nloc, nx); b.st[0] = nloc; b.st[1] = nx; }
        const unsigned old = xb_add(&bar[XB_XSUB(b.x)], 1u);
        const unsigned gen = old / nloc;
        if (old + 1u == (gen + 1u) * nloc) {
            __builtin_amdgcn_fence(__ATOMIC_RELEASE, "agent");
            asm volatile("s_waitcnt vmcnt(0)" ::: "memory");
            const unsigned og = xb_add(&bar[XB_TOP], 1u);
            const unsigned tg = og / nx;
            if (og + 1u == (tg + 1u) * nx) xb_add(&bar[XB_TOPGEN], 1u);
            else XB_SPIN(xb_ld(&bar[XB_TOPGEN]) == tg, bar);
            __builtin_amdgcn_fence(__ATOMIC_ACQUIRE, "agent");
            xb_add(&bar[XB_XGEN(b.x)], 1u);
            asm volatile("s_waitcnt vmcnt(0)" ::: "memory");
        } else {
            XB_SPIN(xb_ld(&bar[XB_XGEN(b.x)]) == gen, bar);
            __builtin_amdgcn_fence(__ATOMIC_ACQUIRE, "agent");
            asm volatile("s_waitcnt vmcnt(0)" ::: "memory");
        }
    }
    __syncthreads();
}

__global__ void __launch_bounds__(512, 2) hymba_fwd(Params p_arg) {
    KP p = (KP)__builtin_amdgcn_kernarg_segment_ptr();
    extern __shared__ __attribute__((aligned(16))) unsigned char lds_raw[];
    LAS unsigned char* lds = (LAS unsigned char*)lds_raw;
    cg::grid_group grid = cg::this_grid();
    volatile LAS unsigned* bst = (volatile LAS unsigned*)(lds + 147392);
    if (threadIdx.x < 2) bst[threadIdx.x] = 0u;
    const int wave_s = __builtin_amdgcn_readfirstlane(threadIdx.x >> 6);
    __syncthreads();
    const XcdBarrier xbar = xcd_barrier_post((unsigned*)(p->ws + WS_CTL) + p->li * XCD_BAR_WORDS, bst);
    const int G = gridDim.x, bx = blockIdx.x;
    const int ph_lo = p->ph_lo, ph_hi = p->ph_hi;
    if (ph_lo < 0) grid.sync();
    KP p0 = p;
#pragma unroll 1
    for (int ph = ph_lo; ph < ph_hi; ++ph) {
        KP p = p0; asm volatile("" : "+s"(p));
        const int l = ph / 9, kind = ph - l * 9;
        int tid = wave_s * 64 + (int)__builtin_amdgcn_mbcnt_hi(~0u, __builtin_amdgcn_mbcnt_lo(~0u, 0u)); asm volatile("" : "+v"(tid));
        const int lane = tid & 63, wave = __builtin_amdgcn_readfirstlane(tid >> 6);
        unsigned char* wsb = p->ws; asm volatile("" : "+s"(wsb));
        bf16_t* WT_IN = (bf16_t*)(wsb + (l ? WS_WIN2 : WS_WIN)); bf16_t* WT_OUT = (bf16_t*)(wsb + (l ? WS_WOUT2 : WS_WOUT)); bf16_t* WT_GU = (bf16_t*)(wsb + WS_WGU); bf16_t* WT_D = (bf16_t*)(wsb + (l ? WS_WD2 : WS_WD));
        const int remG1 = (33 * 22) % G, remG3 = (33 * 44) % G;
        float* X = (float*)(wsb + WS_X); bf16_t* ACT = (bf16_t*)(wsb + WS_ACT); bf16_t* Pb = (bf16_t*)(wsb + WS_P);
        if (ph == 18) {
            const int gid = bx * 512 + tid, gsz = G * 512;
            for (int idx = gid; idx < 160 * 512; idx += gsz) { const int row = 8192 + (idx >> 9), c4 = (idx & 511) * 4; f32x4 v = *(const f32x4*)(X + (size_t)row * D + c4);
                f32x4 t[11];
#pragma unroll
                for (int kp = 0; kp < 11; ++kp) t[kp] = *(const f32x4*)((const float*)(wsb + WS_LS) + ((size_t)kp * 160 + (row - 8192)) * D + c4);
#pragma unroll
                for (int kp = 0; kp < 11; ++kp) v = v + t[kp];
                float* o = (row < NPROMPT) ? p->out + O_YP + ((size_t)(4096 + row - LP - 16)) * D + c4 : p->out + O_YS + (size_t)(row - NPROMPT) * D + c4; *(f32x4*)o = v; }
        } else if (kind == 0) {
            LAS float* scr = (LAS float*)(lds + wave * 18432);
            const int gw = bx * 8 + wave, NGW = G * 8;
            constexpr int I_IN = 32 * 88, I_OUT = 32 * 32, I_G = 32 * 88, I_D = 88 * 32, NIT = I_IN + I_OUT + 2 * I_G + I_D;
            const bool skip_i = (l == 1) && remG1 != 0, skip_od = (l == 1) && remG3 != 0, skip_g = (l == 1) && G > 88, skip_d0 = (l == 0) && G > 32;
            for (int it = gw; it < NIT; it += NGW) { int r = it;
                if (r < I_IN) { if (!skip_i) transpose_item(p->w_in + (size_t)l * D * DIN, D, DIN, WT_IN, 3, scr, r, lane); continue; } r -= I_IN;
                if (r < I_OUT) { if (!skip_od) transpose_item(p->w_out + (size_t)l * D * D, D, D, WT_OUT, 3, scr, r, lane); continue; } r -= I_OUT;
                if (r < I_G) { if (!skip_g) transpose_item(p->w_gate + (size_t)l * D * DFF, D, DFF, WT_GU, 1, scr, r, lane); continue; } r -= I_G;
                if (r < I_G) { transpose_item(p->w_up + (size_t)l * D * DFF, D, DFF, WT_GU, 2, scr, r, lane); continue; } r -= I_G;
                if (!skip_od && !skip_d0) transpose_item(p->w_down + (size_t)l * DFF * D, DFF, D, WT_D, 3, scr, r, lane); }
#define SRC_ROW(m) ((l == 0) ? (((m) < NPROMPT) ? ((((m) % LP) < 16) ? p->meta + (size_t)((m) % LP) * D : p->x_prompt + ((size_t)((m) / LP) * 4096 + ((m) % LP) - 16) * D) : (((m) < NTOK) ? p->x_sample + (size_t)((m) - NPROMPT) * D : (const float*)nullptr)) : (const float*)(X + (size_t)(m) * D))
            for (int m = gw; m + NGW < 8192 + NGW && m < 8192; m += 2 * NGW) { const int m1 = m + NGW;
                if (m1 < 8192) norm_row2(SRC_ROW(m), SRC_ROW(m1), p->norm_mix + l * D, ACT + (size_t)m * D, ACT + (size_t)m1 * D, nullptr, nullptr, lane);
                else norm_row(SRC_ROW(m), p->norm_mix + l * D, ACT + (size_t)m * D, nullptr, lane, nullptr, 0); }
            for (int m = 8192 + gw; m < MP; m += NGW) { const float* src = SRC_ROW(m); float* xc = (l == 0) ? X + (size_t)m * D : nullptr;
                const bool tl = (l == 1) && m < NTOK;
                norm_row(src, p->norm_mix + l * D, ACT + (size_t)m * D, tl ? X + (size_t)m * D : xc, lane, (const float*)(wsb + WS_LS) + (size_t)(tl ? m - 8192 : 0) * D, tl ? 11 : 0); }
#undef SRC_ROW
        } else if (kind == 1) {
            pg8::Gemm g{ACT, WT_IN, MP, DIN, D}; pg8::StaticOrder S; S.init(MP, DIN, D, G, bx, false); pg8::EpiBf16 E{Pb, DIN};
#ifndef NO_G1
            pg8::gemm_phase<pg8::EpiBf16>(lds, g, S, E, tid);
#endif
            if (l == 0 && remG1 != 0 && bx >= remG1) {
                LAS float* scr = (LAS float*)(lds + wave * 18432);
                for (int it = (bx - remG1) * 8 + wave; it < 32 * 88; it += (G - remG1) * 8) transpose_item(p->w_in + (size_t)D * DIN, D, DIN, (bf16_t*)(wsb + WS_WIN2), 3, scr, it, lane); }
        } else if (kind == 2) {
#ifndef NO_ATTN
#pragma unroll 1
            for (int it = bx; it < NITEM; it += G) attn_item(p, l, it, lds, tid);
#endif
#ifndef NO_CHUNK
#pragma unroll 1
            for (int it = (bx + G - (136 % G)) % G; it < NITEM; it += G) chunk_item(p, l, 0, it, lds, tid);
#pragma unroll 1
            for (int it = (bx + 2 * G - (272 % G)) % G; it < NITEM; it += G) chunk_item(p, l, 1, it, lds, tid);
#endif
        } else if (kind == 3) {
#ifndef NO_SCAN
            scan_phase(p, l, tid);
#endif
        } else if (kind == 4) {
#ifndef NO_FIN
#pragma unroll 1
            for (int it = bx; it < 2 * NITEM; it += G) { if (it < NITEM) finish_item(p, l, 0, it, lds, tid); else finish_item(p, l, 1, it - NITEM, lds, tid); }
#endif
        } else if (kind == 5 || kind == 8) {
            const int Kd = kind == 5 ? D : DFF;
            pg8::Gemm g{kind == 5 ? ACT : Pb, kind == 5 ? WT_OUT : WT_D, MP, D, Kd}; pg8::StaticOrder S; S.init(MP, D, Kd, G, bx, true);
            pg8::EpiResid E{p->dummy ? (float*)(wsb + WS_LS) + (size_t)16 * 160 * D : X, (kind == 8 && l == 1) ? p->out : nullptr, Kd / 64, (float*)(wsb + WS_LS), p->meta, (kind == 5 && l == 0 && !p->dummy) ? p->x_prompt : nullptr,
                               (kind == 5) ? (bf16_t*)(wsb + WS_LS + WS_HB_OFF) : nullptr, p->norm_ffn + l * D, (float*)(wsb + WS_CTL + WS_RSF_OFF) + (size_t)l * MP};
#ifndef NO_G24
            pg8::gemm_phase<pg8::EpiResid>(lds, g, S, E, tid);
#endif
            if (kind == 5 && l == 0 && G > 32 && bx >= 32) {
                LAS float* scr = (LAS float*)(lds + wave * 18432);
                for (int it = (bx - 32) * 8 + wave; it < 88 * 32; it += (G - 32) * 8) transpose_item(p->w_down, DFF, D, (bf16_t*)(wsb + WS_WD), 3, scr, it, lane); }
            if (kind == 8 && l == 0 && G > 88 && bx >= 88) {
                LAS float* scr = (LAS float*)(lds + wave * 18432);
                for (int it = (bx - 88) * 8 + wave; it < 32 * 88; it += (G - 88) * 8) transpose_item(p->w_gate + (size_t)D * DFF, D, DFF, WT_GU, 1, scr, it, lane); }
        } else if (kind == 6) {
            const int gw = bx * 8 + wave, NGW = G * 8;
            bf16_t* HB = (bf16_t*)(wsb + WS_LS + WS_HB_OFF); float* RSF = (float*)(wsb + WS_CTL + WS_RSF_OFF) + (size_t)l * MP;
            for (int m = 8192 + gw; m < MP; m += NGW) { const bool tl = m < NTOK;
                norm_row(tl ? X + (size_t)m * D : nullptr, p->norm_ffn + l * D, HB + (size_t)m * D, tl ? X + (size_t)m * D : nullptr, lane, (const float*)(wsb + WS_LS) + (size_t)(tl ? m - 8192 : 0) * D, tl ? 4 : 0, RSF + m); }
        } else {
            pg8::Gemm g{(const bf16_t*)(wsb + WS_LS + WS_HB_OFF), WT_GU, MP, 2 * DFF, D}; pg8::StaticOrder S; S.init(MP, 2 * DFF, D, G, bx, false); pg8::EpiSwiglu E{Pb, (const float*)(wsb + WS_CTL + WS_RSF_OFF) + (size_t)l * MP};
#ifndef NO_G3
            pg8::gemm_phase<pg8::EpiSwiglu>(lds, g, S, E, tid);
#endif
            if (l == 0 && remG3 != 0 && bx >= remG3) {
                LAS float* scr = (LAS float*)(lds + wave * 18432);
                for (int it = (bx - remG3) * 8 + wave; it < 32 * 32 + 88 * 32; it += (G - remG3) * 8) {
                    if (it < 32 * 32) transpose_item(p->w_out + (size_t)D * D, D, D, (bf16_t*)(wsb + WS_WOUT2), 3, scr, it, lane);
                    else transpose_item(p->w_down + (size_t)DFF * D, DFF, D, (bf16_t*)(wsb + WS_WD2), 3, scr, it - 32 * 32, lane); } }
        }
        if (ph + 1 < ph_hi) xcd_barrier(xbar, tid);
    }
}

extern "C" void kernel_launch(void* const* d_in, const int* in_sizes, int n_in, void* d_out, int out_size, void* d_ws, size_t ws_size, hipStream_t stream) {
    static int grid = 0;
    if (grid == 0) {
        int dev = 0, cus = 0, per_cu = 0;
        hipGetDevice(&dev); hipDeviceGetAttribute(&cus, hipDeviceAttributeMultiprocessorCount, dev);
        hipFuncSetAttribute((const void*)hymba_fwd, hipFuncAttributeMaxDynamicSharedMemorySize, LDS_BYTES);
        hipOccupancyMaxActiveBlocksPerMultiprocessor(&per_cu, (const void*)hymba_fwd, 512, LDS_BYTES);
        if (per_cu < 1) { fprintf(stderr, "occupancy query says %d blocks/CU\n", per_cu); per_cu = 1; }
        if (per_cu > 1) per_cu = 1;
        grid = cus * per_cu;
        if (ws_size < WS_END) fprintf(stderr, "workspace too small: %zu < %zu\n", ws_size, (size_t)WS_END);
    }
    if (hipMemsetAsync((char*)d_ws + WS_CTL, 0, CTL_BYTES, stream) != hipSuccess) { fprintf(stderr, "memset failed\n"); return; }
    Params p{};
    const float** pp = (const float**)&p;
    for (int i = 0; i < 20; ++i) pp[i] = (const float*)d_in[i];
    p.out = (float*)d_out; p.ws = (unsigned char*)d_ws;
#ifdef REP_PH
    { const int cuts[4][3] = {{0, REP_PH + 1, 0}, {REP_PH, REP_PH + 1, 1}, {REP_PH + 1, 19, 0}};
      for (int i = 0; i < 3; ++i) { p.ph_lo = cuts[i][0]; p.ph_hi = cuts[i][1]; p.dummy = cuts[i][2]; p.li = i; void* args[] = {&p};
        hipError_t e = hipLaunchCooperativeKernel((const void*)hymba_fwd, dim3(grid), dim3(512), args, LDS_BYTES, stream);
        if (e != hipSuccess) { fprintf(stderr, "launch failed: %s\n", hipGetErrorString(e)); break; } } }
#else
    p.ph_lo = 0; p.ph_hi = 19; void* args[] = {&p};
    hipError_t e = hipLaunchCooperativeKernel((const void*)hymba_fwd, dim3(grid), dim3(512), args, LDS_BYTES, stream);
    if (e != hipSuccess) fprintf(stderr, "cooperative launch failed: %s (grid %d)\n", hipGetErrorString(e), grid);
#endif
}
```

```cpp
#include <hip/hip_runtime.h>
#include <hip/hip_cooperative_groups.h>
#include <cstdio>
#include <cstdint>
#include <cmath>
namespace cg = cooperative_groups;

#define LAS __attribute__((address_space(3)))
typedef unsigned short bf16_t;
typedef short bf16x8 __attribute__((ext_vector_type(8)));
typedef float f32x4 __attribute__((ext_vector_type(4)));
typedef unsigned u32x2 __attribute__((ext_vector_type(2)));
typedef unsigned u32x4 __attribute__((ext_vector_type(4)));

constexpr int D = 2048, DIN = 5632, DFF = 5632, LP = 4112, NPROMPT = 2 * LP  , NSAMP = 128, NTOK = NPROMPT + NSAMP  , MP = 8448;
constexpr int PAST = 16384;
constexpr float EPS = 1e-6f;
constexpr int C_QA = 0, C_KA = 1024, C_VA = 1280, C_QB = 1536, C_FB = 2048, C_IB = 2560, C_GB = 3072, C_QC = 3584, C_KC = 4096, C_VC = 4608, C_GC = 5120;
constexpr size_t O_YP = 0, O_YS = 16777216, O_CKP = 17039360, O_CVP = 17170432, O_SHP = 17301504, O_SRP = 17563648, O_CKS = 17825792, O_CVS = 19922944, O_SHS = 22020096, O_SRS = 26214400;
constexpr size_t SZ_WIN = (size_t)DIN * D * 2, SZ_WOUT = (size_t)D * D * 2, SZ_WGU = (size_t)2 * DFF * D * 2, SZ_WD = (size_t)D * DFF * 2;
constexpr size_t WS_WIN = 0, WS_WOUT = WS_WIN + SZ_WIN, WS_WGU = WS_WOUT + SZ_WOUT, WS_WD = WS_WGU + SZ_WGU;
constexpr size_t WS_X = WS_WD + SZ_WD;
constexpr size_t WS_ACT = WS_X + (size_t)MP * D * 4;
constexpr size_t WS_P = WS_ACT + (size_t)MP * D * 2;
constexpr size_t WS_INTRA = WS_P + (size_t)MP * DIN * 2;
constexpr size_t WS_QI = WS_INTRA + (size_t)MP * 1024 * 4;
constexpr int NITEM = 648;
constexpr size_t WS_LS = WS_QI + (size_t)MP * 1024 * 2;
constexpr size_t WS_DEC = WS_LS + (size_t)2 * NITEM * 16384 * 4;
constexpr size_t WS_CTL = WS_DEC + (size_t)NITEM * 128 * 4;
constexpr size_t CTL_BYTES = 65536;
constexpr size_t WS_WIN2 = WS_CTL + CTL_BYTES, WS_WOUT2 = WS_WIN2 + SZ_WIN, WS_WD2 = WS_WOUT2 + SZ_WOUT;
constexpr size_t WS_END = WS_WD2 + SZ_WD;

constexpr int LDS_BYTES = 147456;

struct Params;
struct Params {
    const float *x_prompt, *x_sample, *cache_k, *cache_v, *state_hgrn, *state_ret, *meta, *norm_mix, *norm_ffn, *w_in, *q_norm, *k_norm, *sinks, *hgrn_lb,
        *hgrn_norm, *ret_norm, *w_out, *w_gate, *w_up, *w_down;
    float* out; unsigned char* ws;
    int ph_lo, ph_hi, dummy, li;
};

__constant__ float INV_A[8] = {1.000000000e+00f, 1.939227432e-01f, 3.760603070e-02f, 7.292664610e-03f, 1.414213562e-03f, 2.742481884e-04f, 5.318295734e-05f, 1.031338525e-05f};
__constant__ float INV_C[64] = {1.000000000e+00f, 8.659643531e-01f, 7.498942018e-01f, 6.493816376e-01f, 5.623413324e-01f, 4.869675338e-01f, 4.216965139e-01f, 3.651741147e-01f, 3.162277639e-01f, 2.738419771e-01f, 2.371373773e-01f, 2.053525001e-01f, 1.778279394e-01f, 1.539926529e-01f, 1.333521456e-01f, 1.154781953e-01f, 1.000000015e-01f, 8.659642935e-02f, 7.498942316e-02f, 6.493816525e-02f, 5.623413250e-02f, 4.869675264e-02f, 4.216964915e-02f, 3.651741147e-02f, 3.162277490e-02f, 2.738419548e-02f, 2.371373773e-02f, 2.053525113e-02f, 1.778279431e-02f, 1.539926510e-02f, 1.333521400e-02f, 1.154781971e-02f, 9.999999776e-03f, 8.659643121e-03f, 7.498942316e-03f, 6.493816152e-03f, 5.623413250e-03f, 4.869675264e-03f, 4.216964822e-03f, 3.651741194e-03f, 3.162277630e-03f, 2.738419687e-03f, 2.371373819e-03f, 2.053525066e-03f, 1.778279431e-03f, 1.539926510e-03f, 1.333521446e-03f, 1.154782018e-03f, 1.000000047e-03f, 8.659643354e-04f, 7.498941850e-04f, 6.493816036e-04f, 5.623413017e-04f, 4.869675322e-04f, 4.216965172e-04f, 3.651741135e-04f, 3.162277571e-04f, 2.738419571e-04f, 2.371373703e-04f, 2.053525095e-04f, 1.778279402e-04f, 1.539926598e-04f, 1.333521504e-04f, 1.154782003e-04f};
__constant__ float LG[4] = {-3.174869716e-02f, -1.574835740e-02f, -7.843177766e-03f, -3.913899418e-03f};

typedef const Params __attribute__((address_space(4)))* KP;

template <class T> __device__ __forceinline__ T* as_global(T* q) { return (T*)(__attribute__((address_space(1))) T*)(unsigned long long)q; }

__device__ __forceinline__ unsigned pk2(float lo, float hi);
__device__ __forceinline__ unsigned f2bf(float f) { return pk2(f, 0.f) & 0xffffu; }
typedef float f32x2_t __attribute__((ext_vector_type(2)));
typedef __bf16 bf16x2_t __attribute__((ext_vector_type(2)));
__device__ __forceinline__ unsigned pk2(float lo, float hi) { const f32x2_t v = {lo, hi}; const bf16x2_t b = __builtin_convertvector(v, bf16x2_t); return __builtin_bit_cast(unsigned, b); }
__device__ __forceinline__ unsigned f2bf_sw(float f) { unsigned u = __builtin_bit_cast(unsigned, f); return (u + 0x7fffu + ((u >> 16) & 1u)) >> 16; }
__device__ __forceinline__ unsigned pk2_sw(float lo, float hi) { return f2bf_sw(lo) | (f2bf_sw(hi) << 16); }
__device__ __forceinline__ float bf_lo(unsigned u) { return __builtin_bit_cast(float, u << 16); }
__device__ __forceinline__ float bf_hi(unsigned u) { return __builtin_bit_cast(float, u & 0xffff0000u); }
__device__ __forceinline__ float wave_sum(float v) {
#pragma unroll
    for (int o = 1; o < 64; o <<= 1) v += __shfl_xor(v, o);
    return v;
}
__device__ __forceinline__ float siluf(float x) { return x * __builtin_amdgcn_rcpf(1.f + __expf(-x)); }
__device__ __forceinline__ void sincos_red(float ang, float& s, float& c) {
    const float n = rintf(ang * 0.15915494309189535f);
    float r = fmaf(-n, 6.2831854820251465f, ang);
    r = fmaf(-n, -1.7484555e-7f, r);
    s = __sinf(r); c = __cosf(r);
}
#define LDS_WAIT() asm volatile("s_waitcnt lgkmcnt(0)" ::: "memory")
#define LDS_SYNC() do { asm volatile("s_waitcnt lgkmcnt(0)" ::: "memory"); __builtin_amdgcn_s_barrier(); asm volatile("" ::: "memory"); } while (0)

namespace pg8 {
constexpr int BM = 256, BK = 64, HALF = 128, HTB = HALF * BK * 2, NXCD = 8, WGM = 8;
__host__ __device__ __forceinline__ int lds_byte(int r, int c) { const int st = (r >> 4) * 2 + (c >> 5), rr = r & 15, cc = c & 31, ob = rr * 64 + cc * 2; return st * 1024 + (ob ^ (((ob >> 9) & 1) << 5)); }
__host__ __device__ __forceinline__ void stage_rc(int b, int& R, int& C) { const int st = b / 1024, sb = b % 1024, swz = sb ^ (((sb >> 9) & 1) << 5); R = (st >> 1) * 16 + swz / 64; C = (st & 1) * 32 + (swz % 64) / 2; }
struct Unit { int pm, pn, k0, nt; };
struct Gemm { const bf16_t* A; const bf16_t* Bt; int M, N, K; };
struct StaticOrder {
    int nM, nN, nwg, G, c, ntk, nExtra;
    __device__ __forceinline__ void init(int M, int N, int K, int G_, int c_, bool tail) { nM = M / BM; nN = N / BM; ntk = K / BK; G = G_; c = c_; nExtra = 0; if (tail) { nM -= 1; nExtra = nN * (ntk / 8); } nwg = nM * nN; }
    __device__ __forceinline__ bool next(int i, Unit& u) const {
        const long L = (long)i * G + c; const bool full = L < nwg; const int ei = full ? 0 : (int)(L - nwg);
        if (!full && ei >= nExtra) return false;
        int wgid = full ? (int)L : 0; { const int q = nwg / NXCD, r = nwg % NXCD, xcd = wgid % NXCD, off = wgid / NXCD; wgid = (xcd < r ? xcd * (q + 1) : r * (q + 1) + (xcd - r) * q) + off; }
        const int nig = WGM * nN, gid = wgid / nig, fm = gid * WGM, gsz = (nM - fm) < WGM ? (nM - fm) : WGM;
        const int pmf = fm + ((wgid % nig) % gsz), pnf = (wgid % nig) / gsz;
        u.pm = full ? pmf : nM; u.pn = full ? pnf : (ei % nN); u.k0 = full ? 0 : 8 * (ei / nN); u.nt = full ? ntk : 8; return true;
    }
};
struct EpiBf16 {
    bf16_t* O; int ldc;
    __device__ __forceinline__ void operator()(const f32x4 (&acc)[2][2][4][2], const Unit& u, int wr, int wc, int fr, int fq) const {
        const int row0 = u.pm * BM + wr * 64 + fr, col0 = u.pn * BM + wc * 32 + 8 * fq;
#pragma unroll
        for (int ai = 0; ai < 2; ++ai)
#pragma unroll
            for (int m = 0; m < 4; ++m) { bf16_t* rowp = O + (size_t)(row0 + ai * HALF + m * 16) * ldc + col0;
#pragma unroll
                for (int bj = 0; bj < 2; ++bj) { const f32x4 v0 = acc[ai][bj][m][0], v1 = acc[ai][bj][m][1]; u32x4 w; w.x = pk2(v0[0], v0[1]); w.y = pk2(v0[2], v0[3]); w.z = pk2(v1[0], v1[1]); w.w = pk2(v1[2], v1[3]);
                    *(u32x4*)(rowp + bj * HALF) = w; } }
    }
};
struct EpiResid {
    float* X; float* out; int ntk; float* part; const float* in_meta; const float* in_prompt;
    __device__ __forceinline__ void operator()(const f32x4 (&acc)[2][2][4][2], const Unit& u, int wr, int wc, int fr, int fq) const {
        const int row0 = u.pm * BM + wr * 64 + fr, col0 = u.pn * BM + wc * 32 + 4 * fq;
        if (u.nt != ntk) {
            float* pb = part + (size_t)(u.k0 >> 3) * (160 * D);
#pragma unroll
            for (int ai = 0; ai < 2; ++ai)
#pragma unroll
                for (int m = 0; m < 4; ++m) { const int r = wr * 64 + fr + ai * HALF + m * 16; float* xr = pb + (size_t)r * D + col0;
                    if (r < 160) {
#pragma unroll
                        for (int bj = 0; bj < 2; ++bj)
#pragma unroll
                            for (int n = 0; n < 2; ++n) *(f32x4*)(xr + bj * HALF + n * 16) = acc[ai][bj][m][n]; } }
            return;
        }
#pragma unroll
        for (int ai = 0; ai < 2; ++ai)
#pragma unroll
            for (int m = 0; m < 4; ++m) { const int row = row0 + ai * HALF + m * 16; float* xr = X + (size_t)row * D + col0; float* orow = nullptr; const float* src = xr;
                const int b = row / LP, t = row - b * LP;
                if (out) { if (t >= 16) orow = out + O_YP + ((size_t)(b * 4096 + t - 16)) * D + col0; }
                if (in_prompt) src = (t < 16) ? in_meta + (size_t)t * D + col0 : in_prompt + ((size_t)(b * 4096 + t - 16)) * D + col0;
#pragma unroll
                for (int bj = 0; bj < 2; ++bj)
#pragma unroll
                    for (int n = 0; n < 2; ++n) { f32x4 v = *(const f32x4*)(src + bj * HALF + n * 16) + acc[ai][bj][m][n]; *(f32x4*)(xr + bj * HALF + n * 16) = v; if (orow) *(f32x4*)(orow + bj * HALF + n * 16) = v; } }
    }
};
struct EpiSwiglu {
    bf16_t* U;
    __device__ __forceinline__ void operator()(const f32x4 (&acc)[2][2][4][2], const Unit& u, int wr, int wc, int fr, int fq) const {
        const int row0 = u.pm * BM + wr * 64 + fr, col0 = u.pn * 128 + wc * 32 + 8 * fq;
#pragma unroll
        for (int ai = 0; ai < 2; ++ai)
#pragma unroll
            for (int m = 0; m < 4; ++m) { bf16_t* rowp = U + (size_t)(row0 + ai * HALF + m * 16) * DFF + col0;
                const f32x4 g0 = acc[ai][0][m][0], u0 = acc[ai][0][m][1], g1 = acc[ai][1][m][0], u1 = acc[ai][1][m][1]; u32x4 w;
                w.x = pk2(siluf(g0[0]) * u0[0], siluf(g0[1]) * u0[1]); w.y = pk2(siluf(g0[2]) * u0[2], siluf(g0[3]) * u0[3]);
                w.z = pk2(siluf(g1[0]) * u1[0], siluf(g1[1]) * u1[1]); w.w = pk2(siluf(g1[2]) * u1[2], siluf(g1[3]) * u1[3]);
                *(u32x4*)rowp = w; }
    }
};

template <class Epi>
__device__ __forceinline__ void gemm_phase(LAS unsigned char* lds, const Gemm g, const StaticOrder& S, const Epi& E, const int tid) {
    const int wid = __builtin_amdgcn_readfirstlane(tid >> 6), lane = tid & 63, wr = wid >> 2, wc = wid & 3, fr = lane & 15, fq = lane >> 4;
    const int K = g.K;
    unsigned voffA[2];
#pragma unroll
    for (int i = 0; i < 2; ++i) { int R, C; stage_rc(tid * 16 + i * 8192, R, C); voffA[i] = (unsigned)(R * K + C) * 2u; }
    const size_t kstep = (size_t)(BK * 2);
    const size_t hstep = (size_t)HALF * K * 2;
    const size_t tstep = 2 * hstep;
    const unsigned ldsw = (unsigned)wid * 1024u;
    const int aoff = lds_byte(wr * 64 + fr, fq * 8), boff = lds_byte(wc * 32 + fr, fq * 8);
#define PG8_SA(b, h) (((b) * 2 + (h)) * HTB)
#define PG8_SB(b, h) ((4 + (b) * 2 + (h)) * HTB)
#define PG8_STAGE(bufoff, gbase, voff) do { _Pragma("unroll") for (int _i = 0; _i < 2; ++_i) \
        __builtin_amdgcn_global_load_lds((const unsigned*)((const char*)(gbase) + (voff)[_i]), (LAS unsigned*)(lds + (bufoff) + ldsw + _i * 8192), 16, 0, 0); } while (0)
#define PG8_LDA(dst, b, h) do { _Pragma("unroll") for (int m = 0; m < 4; ++m) _Pragma("unroll") for (int k = 0; k < 2; ++k) dst[m][k] = *(const LAS bf16x8*)(lds + PG8_SA(b, h) + aoff + m * 2048 + k * 1024); } while (0)
#define PG8_LDB(dst, b, h) do { _Pragma("unroll") for (int n = 0; n < 2; ++n) _Pragma("unroll") for (int k = 0; k < 2; ++k) dst[n][k] = *(const LAS bf16x8*)(lds + PG8_SB(b, h) + boff + n * 2048 + k * 1024); } while (0)
#define PG8_MMA(ai, bj, At, Bt) do { __builtin_amdgcn_s_setprio(1); _Pragma("unroll") for (int m = 0; m < 4; ++m) _Pragma("unroll") for (int n = 0; n < 2; ++n) _Pragma("unroll") for (int k = 0; k < 2; ++k) \
        acc[ai][bj][m][n] = __builtin_amdgcn_mfma_f32_16x16x32_bf16(Bt[n][k], At[m][k], acc[ai][bj][m][n], 0, 0, 0); __builtin_amdgcn_s_setprio(0); } while (0)
#define PG8_WAIT_V(n) asm volatile("s_waitcnt vmcnt(" #n ")" ::: "memory")
#define PG8_WAIT_L(n) asm volatile("s_waitcnt lgkmcnt(" #n ")" ::: "memory")
#define PG8_BAR __builtin_amdgcn_s_barrier()
#define PG8_SCHED __builtin_amdgcn_sched_barrier(0)
    Unit cur, nxt; int ui = 0;
    if (!S.next(0, cur)) return;
    f32x4 acc[2][2][4][2];
#pragma unroll
    for (int a = 0; a < 2; ++a)
#pragma unroll
        for (int b = 0; b < 2; ++b)
#pragma unroll
            for (int m = 0; m < 4; ++m)
#pragma unroll
                for (int n = 0; n < 2; ++n) acc[a][b][m][n] = (f32x4){0.f, 0.f, 0.f, 0.f};
    bf16x8 At[4][2], B0[2][2], B1[2][2];
    const char* cA = (const char*)g.A + (size_t)cur.pm * tstep + (size_t)cur.k0 * kstep; const char* cB = (const char*)g.Bt + (size_t)cur.pn * tstep + (size_t)cur.k0 * kstep;
    PG8_STAGE(PG8_SB(0, 0), cB, voffA); PG8_STAGE(PG8_SB(0, 1), cB + hstep, voffA); PG8_STAGE(PG8_SA(0, 0), cA, voffA); PG8_STAGE(PG8_SA(0, 1), cA + hstep, voffA);
    if (wr == 1) PG8_BAR;
    PG8_WAIT_V(2); PG8_BAR;
    PG8_STAGE(PG8_SB(1, 0), cB + kstep, voffA); PG8_STAGE(PG8_SA(1, 0), cA + kstep, voffA); PG8_STAGE(PG8_SB(1, 1), cB + hstep + kstep, voffA);
    PG8_WAIT_V(6); PG8_BAR;
    for (;;) {
        const bool has_next = S.next(ui + 1, nxt);
        const char* nA = has_next ? (const char*)g.A + (size_t)nxt.pm * tstep + (size_t)nxt.k0 * kstep : cA; const char* nB = has_next ? (const char*)g.Bt + (size_t)nxt.pn * tstep + (size_t)nxt.k0 * kstep : cB;
        const int nt = cur.nt;
        for (int t = 0; t < nt; t += 2) {
            const bool last = (t == nt - 2);
            const char* a1 = cA + (size_t)(t + 1) * kstep;
            const char* a2 = last ? nA : cA + (size_t)(t + 2) * kstep; const char* b2 = last ? nB : cB + (size_t)(t + 2) * kstep;
            const char* a3 = a2 + kstep; const char* b3 = b2 + kstep;
            PG8_LDB(B0, 0, 0); PG8_LDB(B1, 0, 1); PG8_SCHED; PG8_LDA(At, 0, 0); PG8_STAGE(PG8_SA(1, 1), a1 + hstep, voffA);
            PG8_WAIT_V(8); PG8_WAIT_L(0); PG8_BAR; PG8_MMA(0, 0, At, B0); PG8_MMA(0, 1, At, B1); PG8_BAR; PG8_SCHED;
            PG8_LDA(At, 0, 1); PG8_STAGE(PG8_SB(0, 0), b2, voffA); PG8_STAGE(PG8_SB(0, 1), b2 + hstep, voffA); PG8_STAGE(PG8_SA(0, 0), a2, voffA);
            PG8_WAIT_V(8); PG8_WAIT_L(0); PG8_BAR; PG8_MMA(1, 0, At, B0); PG8_MMA(1, 1, At, B1); PG8_BAR; PG8_SCHED;
            PG8_LDB(B0, 1, 0); PG8_LDB(B1, 1, 1); PG8_SCHED; PG8_LDA(At, 1, 0); PG8_STAGE(PG8_SA(0, 1), a2 + hstep, voffA);
            PG8_WAIT_V(8); PG8_WAIT_L(0); PG8_BAR; PG8_MMA(0, 0, At, B0); PG8_MMA(0, 1, At, B1); PG8_BAR; PG8_SCHED;
            PG8_LDA(At, 1, 1); PG8_STAGE(PG8_SB(1, 0), b3, voffA); PG8_STAGE(PG8_SB(1, 1), b3 + hstep, voffA); PG8_STAGE(PG8_SA(1, 0), a3, voffA);
            PG8_WAIT_V(8); PG8_WAIT_L(0); PG8_BAR; PG8_MMA(1, 0, At, B0); PG8_MMA(1, 1, At, B1); PG8_BAR; PG8_SCHED;
        }
        if (wr == 0) PG8_BAR;
        E(acc, cur, wr, wc, fr, fq);
        if (!has_next) break;
#pragma unroll
        for (int a = 0; a < 2; ++a)
#pragma unroll
            for (int b = 0; b < 2; ++b)
#pragma unroll
                for (int m = 0; m < 4; ++m)
#pragma unroll
                    for (int n = 0; n < 2; ++n) acc[a][b][m][n] = (f32x4){0.f, 0.f, 0.f, 0.f};
        cur = nxt; cA = nA; cB = nB; ++ui;
        if (wr == 1) PG8_BAR;
    }
    PG8_WAIT_V(0);
    PG8_BAR;
#undef PG8_SA
#undef PG8_SB
#undef PG8_STAGE
#undef PG8_LDA
#undef PG8_LDB
#undef PG8_MMA
#undef PG8_WAIT_V
#undef PG8_WAIT_L
#undef PG8_BAR
#undef PG8_SCHED
}
}

__device__ __forceinline__ void transpose_item(const float* W, int K, int N, bf16_t* WT, int mode, LAS float* scr, int item, int lane) {
    const int nblk = N / 64, kb = item / nblk, nb = item - kb * nblk, k0 = 64 * kb, n0 = 64 * nb;
    const int lr = lane >> 4, lc = (lane & 15) * 4;
    f32x4 v[16];
#pragma unroll
    for (int i = 0; i < 16; ++i) v[i] = *(const f32x4*)(W + (size_t)(k0 + 4 * i + lr) * N + n0 + lc);
#pragma unroll
    for (int i = 0; i < 16; ++i) { LAS float* d = scr + (4 * i + lr) * 65 + lc; d[0] = v[i][0]; d[1] = v[i][1]; d[2] = v[i][2]; d[3] = v[i][3]; }
    LDS_WAIT();
    const int c = lane & 7;
#pragma unroll
    for (int j = 0; j < 8; ++j) { const int n = (lane >> 3) + 8 * j; const LAS float* s = scr + (8 * c) * 65 + n;
        u32x4 o; o.x = pk2(s[0 * 65], s[1 * 65]); o.y = pk2(s[2 * 65], s[3 * 65]); o.z = pk2(s[4 * 65], s[5 * 65]); o.w = pk2(s[6 * 65], s[7 * 65]);
        const int nn = n0 + n;
        const int orow = (mode == 0) ? nn
                       : (mode == 3) ? ((nn & ~31) + 16 * ((nn & 7) >> 2) + 4 * ((nn & 31) >> 3) + (nn & 3))
                       : (256 * (nn >> 7) + 128 * ((nn & 7) >> 2) + 32 * ((nn & 127) >> 5) + 16 * (mode - 1) + 4 * ((nn & 31) >> 3) + (nn & 3));
        *(u32x4*)(WT + (size_t)orow * K + k0 + 8 * c) = o; }
    LDS_WAIT();
}
__device__ __forceinline__ void norm_row(const float* xrow, const float* g, bf16_t* orow, float* xcopy, int lane, const float* part, int nparts) {
    f32x4 v[8]; float s = 0.f;
#pragma unroll
    for (int j = 0; j < 8; ++j) v[j] = xrow ? ((const f32x4*)xrow)[lane + 64 * j] : (f32x4){0.f, 0.f, 0.f, 0.f};
    for (int kp = 0; kp + 3 < nparts; kp += 4) {
        f32x4 t[4][8];
#pragma unroll
        for (int q = 0; q < 4; ++q)
#pragma unroll
            for (int j = 0; j < 8; ++j) t[q][j] = ((const f32x4*)(part + (size_t)(kp + q) * (160 * D)))[lane + 64 * j];
#pragma unroll
        for (int q = 0; q < 4; ++q)
#pragma unroll
            for (int j = 0; j < 8; ++j) v[j] = v[j] + t[q][j]; }
    for (int kp = nparts & ~3; kp < nparts; ++kp) {
#pragma unroll
        for (int j = 0; j < 8; ++j) v[j] = v[j] + ((const f32x4*)(part + (size_t)kp * (160 * D)))[lane + 64 * j]; }
#pragma unroll
    for (int j = 0; j < 8; ++j) s += (v[j][0] * v[j][0] + v[j][1] * v[j][1]) + (v[j][2] * v[j][2] + v[j][3] * v[j][3]);
    const float r = rsqrtf(wave_sum(s) * (1.f / D) + EPS);
#pragma unroll
    for (int j = 0; j < 8; ++j) { const f32x4 gg = ((const f32x4*)g)[lane + 64 * j]; u32x2 w; w.x = pk2(v[j][0] * r * gg[0], v[j][1] * r * gg[1]); w.y = pk2(v[j][2] * r * gg[2], v[j][3] * r * gg[3]);
        ((u32x2*)orow)[lane + 64 * j] = w; if (xcopy) ((f32x4*)xcopy)[lane + 64 * j] = v[j]; }
}

__device__ __forceinline__ void norm_row2(const float* x0, const float* x1, const float* g, bf16_t* o0, bf16_t* o1, float* c0, float* c1, int lane) {
    f32x4 a[8], b[8]; float s0 = 0.f, s1 = 0.f;
#pragma unroll
    for (int j = 0; j < 8; ++j) a[j] = x0 ? ((const f32x4*)x0)[lane + 64 * j] : (f32x4){0.f, 0.f, 0.f, 0.f};
#pragma unroll
    for (int j = 0; j < 8; ++j) b[j] = x1 ? ((const f32x4*)x1)[lane + 64 * j] : (f32x4){0.f, 0.f, 0.f, 0.f};
#pragma unroll
    for (int j = 0; j < 8; ++j) { s0 += (a[j][0] * a[j][0] + a[j][1] * a[j][1]) + (a[j][2] * a[j][2] + a[j][3] * a[j][3]); s1 += (b[j][0] * b[j][0] + b[j][1] * b[j][1]) + (b[j][2] * b[j][2] + b[j][3] * b[j][3]); }
    const float r0 = rsqrtf(wave_sum(s0) * (1.f / D) + EPS), r1 = rsqrtf(wave_sum(s1) * (1.f / D) + EPS);
#pragma unroll
    for (int j = 0; j < 8; ++j) { const f32x4 gg = ((const f32x4*)g)[lane + 64 * j]; u32x2 w;
        w.x = pk2(a[j][0] * r0 * gg[0], a[j][1] * r0 * gg[1]); w.y = pk2(a[j][2] * r0 * gg[2], a[j][3] * r0 * gg[3]); ((u32x2*)o0)[lane + 64 * j] = w; if (c0) ((f32x4*)c0)[lane + 64 * j] = a[j];
        w.x = pk2(b[j][0] * r1 * gg[0], b[j][1] * r1 * gg[1]); w.y = pk2(b[j][2] * r1 * gg[2], b[j][3] * r1 * gg[3]); ((u32x2*)o1)[lane + 64 * j] = w; if (c1) ((f32x4*)c1)[lane + 64 * j] = b[j]; }
}

__device__ __forceinline__ bf16x8 frag(const LAS bf16_t* base, int row0, int ld, int k0, int fr, int fq) { return *(const LAS bf16x8*)(base + (row0 + fr) * ld + k0 + fq * 8); }
typedef short v4i16_t __attribute__((ext_vector_type(4)));
__device__ __forceinline__ bf16x8 frag_tr(const LAS bf16_t* base, int ld, int k0, int n0, int lane) {
    const LAS bf16_t* a = base + (k0 + (lane >> 4) * 8 + ((lane >> 2) & 3)) * ld + n0 + 4 * (lane & 3);
    const v4i16_t lo = __builtin_amdgcn_ds_read_tr16_b64_v4i16((LAS v4i16_t*)a), hi = __builtin_amdgcn_ds_read_tr16_b64_v4i16((LAS v4i16_t*)(a + 4 * ld));
    return (bf16x8){lo[0], lo[1], lo[2], lo[3], hi[0], hi[1], hi[2], hi[3]};
}
#define MFMA16(a, b, c) __builtin_amdgcn_mfma_f32_16x16x32_bf16((a), (b), (c), 0, 0, 0)

__device__ __forceinline__ void attn_item(KP p, int l, int it, LAS unsigned char* lds, int tid) {
    const int lane = tid & 63, w = tid >> 6, fr = lane & 15, fq = lane >> 4;
    LAS bf16_t* Qs = (LAS bf16_t*)lds;
    LAS bf16_t* Ks = (LAS bf16_t*)(lds + 36864);
    LAS bf16_t* Vt = (LAS bf16_t*)(lds + 64512);
    LAS float* CS = (LAS float*)(lds + 92160);
    const bf16_t* P = (const bf16_t*)(as_global(p->ws) + WS_P);
    bf16_t* MIX = (bf16_t*)(as_global(p->ws) + WS_ACT);
    const bool samp = it >= 520;
    int b, hkv, q0pos, nq, rowq0;
    if (!samp) { b = it / 260; const int rem = it - b * 260; hkv = rem / 65; const int ch = rem - hkv * 65; q0pos = ch ? 16 + 64 * (ch - 1) : 0; nq = ch ? 64 : 16; rowq0 = b * LP + q0pos; }
    else { const int s = it - 520; b = s >> 2; hkv = s & 3; q0pos = PAST; nq = 4; rowq0 = NPROMPT + b * 4; }
    const int sub = tid & 15, r16 = tid >> 4;
    const f32x4 kn = *(const f32x4*)(as_global(p->k_norm) + l * 64 + sub * 4), qn = *(const f32x4*)(as_global(p->q_norm) + l * 64 + sub * 4);
    f32x4 kv[6], vv[6]; u32x2 qraw[8];
    if (!samp) {
#pragma unroll
        for (int ps = 0; ps < 6; ++ps) { const int pos = q0pos - 128 + ps * 32 + r16; const bf16_t* pr = P + (size_t)(b * LP + (pos < 0 ? 0 : pos)) * DIN + hkv * 64 + sub * 4;
            const u32x2 a = *(const u32x2*)(pr + C_KA), c = *(const u32x2*)(pr + C_VA);
            kv[ps] = (f32x4){bf_lo(a.x), bf_hi(a.x), bf_lo(a.y), bf_hi(a.y)}; vv[ps] = (f32x4){bf_lo(c.x), bf_hi(c.x), bf_lo(c.y), bf_hi(c.y)};
            if (pos < 0) { kv[ps] = (f32x4){0.f, 0.f, 0.f, 0.f}; vv[ps] = (f32x4){0.f, 0.f, 0.f, 0.f}; } }
    } else {
#pragma unroll
        for (int ps = 0; ps < 4; ++ps) { const int j = ps * 32 + r16; const size_t o = ((size_t)((l * 32 + b) * 128 + j)) * 256 + hkv * 64 + sub * 4; kv[ps] = *(const f32x4*)(as_global(p->cache_k) + o); vv[ps] = *(const f32x4*)(as_global(p->cache_v) + o); }
        { kv[4] = (f32x4){0.f, 0.f, 0.f, 0.f}; vv[4] = kv[4]; kv[5] = kv[4]; vv[5] = kv[4];
          if (r16 < 4) { const bf16_t* pr = P + (size_t)(NPROMPT + b * 4 + r16) * DIN + hkv * 64 + sub * 4; const u32x2 a = *(const u32x2*)(pr + C_KA), c = *(const u32x2*)(pr + C_VA);
              kv[4] = (f32x4){bf_lo(a.x), bf_hi(a.x), bf_lo(a.y), bf_hi(a.y)}; vv[4] = (f32x4){bf_lo(c.x), bf_hi(c.x), bf_lo(c.y), bf_hi(c.y)}; } }
    }
#pragma unroll
    for (int ps = 0; ps < 8; ++ps) { const int rowl = ps * 32 + r16, g = rowl >> 6, t = rowl & 63; qraw[ps] = (u32x2){0u, 0u};
        if (t < nq) qraw[ps] = *(const u32x2*)(P + (size_t)(rowq0 + t) * DIN + C_QA + (hkv * 4 + g) * 64 + sub * 4); }
#pragma unroll
    for (int r = 0; r < 3; ++r) { const int e = tid + r * 512; const int pos = q0pos - 128 + (e >> 3); float s, c; sincos_red((float)pos * INV_A[e & 7], s, c); CS[2 * e] = c; CS[2 * e + 1] = s; }
    LDS_SYNC();
#pragma unroll
    for (int ps = 0; ps < 6; ++ps) {
        const int j = ps * 32 + r16; const int pos = q0pos - 128 + j;
        const bool proc = samp ? (j >= 128 && j < 132) : (pos >= 0);
        f32x4 k4 = kv[ps]; const f32x4 v4 = vv[ps];
        float ss = (k4[0] * k4[0] + k4[1] * k4[1]) + (k4[2] * k4[2] + k4[3] * k4[3]);
        ss += __shfl_xor(ss, 1); ss += __shfl_xor(ss, 2); ss += __shfl_xor(ss, 4); ss += __shfl_xor(ss, 8);
        if (proc) { const float r = rsqrtf(ss * (1.f / 64.f) + EPS); k4 = k4 * r * kn; }
        f32x4 pt; pt[0] = __shfl_xor(k4[0], 2); pt[1] = __shfl_xor(k4[1], 2); pt[2] = __shfl_xor(k4[2], 2); pt[3] = __shfl_xor(k4[3], 2);
        { const LAS f32x4* cs = (const LAS f32x4*)(CS + (j * 8 + (sub & 1) * 4) * 2); const f32x4 c01 = cs[0], c23 = cs[1];
          const float cc[4] = {c01[0], c01[2], c23[0], c23[2]}, sn[4] = {c01[1], c01[3], c23[1], c23[3]};
          if (proc && sub < 4) {
#pragma unroll
              for (int e = 0; e < 4; ++e) k4[e] = (sub < 2) ? (k4[e] * cc[e] - pt[e] * sn[e]) : (k4[e] * cc[e] + pt[e] * sn[e]); } }
        u32x2 kw; kw.x = pk2(k4[0], k4[1]); kw.y = pk2(k4[2], k4[3]); *(LAS u32x2*)(Ks + j * 72 + sub * 4) = kw;
        { u32x2 vw; vw.x = pk2(v4[0], v4[1]); vw.y = pk2(v4[2], v4[3]); *(LAS u32x2*)(Vt + j * 72 + sub * 4) = vw; }
        if (!samp) { if (j >= 128 && pos >= LP - 128) { const size_t o = ((size_t)((l * 2 + b) * 128 + pos - (LP - 128))) * 256 + hkv * 64 + sub * 4; *(f32x4*)(as_global(p->out) + O_CKP + o) = k4; *(f32x4*)(as_global(p->out) + O_CVP + o) = v4; } }
        else if (j >= 4 && j < 132) { const size_t o = ((size_t)((l * 32 + b) * 128 + j - 4)) * 256 + hkv * 64 + sub * 4; *(f32x4*)(as_global(p->out) + O_CKS + o) = k4; *(f32x4*)(as_global(p->out) + O_CVS + o) = v4; }
    }
#pragma unroll
    for (int ps = 0; ps < 8; ++ps) {
        const int rowl = ps * 32 + r16, t = rowl & 63;
        f32x4 q4 = (f32x4){bf_lo(qraw[ps].x), bf_hi(qraw[ps].x), bf_lo(qraw[ps].y), bf_hi(qraw[ps].y)};
        float ss = (q4[0] * q4[0] + q4[1] * q4[1]) + (q4[2] * q4[2] + q4[3] * q4[3]);
        ss += __shfl_xor(ss, 1); ss += __shfl_xor(ss, 2); ss += __shfl_xor(ss, 4); ss += __shfl_xor(ss, 8);
        { const float r = rsqrtf(ss * (1.f / 64.f) + EPS); q4 = q4 * r * qn; }
        f32x4 pt; pt[0] = __shfl_xor(q4[0], 2); pt[1] = __shfl_xor(q4[1], 2); pt[2] = __shfl_xor(q4[2], 2); pt[3] = __shfl_xor(q4[3], 2);
        { const LAS f32x4* cs = (const LAS f32x4*)(CS + ((128 + t) * 8 + (sub & 1) * 4) * 2); const f32x4 c01 = cs[0], c23 = cs[1];
          const float cc[4] = {c01[0], c01[2], c23[0], c23[2]}, sn[4] = {c01[1], c01[3], c23[1], c23[3]};
          if (sub < 4) {
#pragma unroll
              for (int e = 0; e < 4; ++e) q4[e] = (sub < 2) ? (q4[e] * cc[e] - pt[e] * sn[e]) : (q4[e] * cc[e] + pt[e] * sn[e]); } }
        q4 = q4 * 0.125f;
        u32x2 qw; qw.x = pk2(q4[0], q4[1]); qw.y = pk2(q4[2], q4[3]); *(LAS u32x2*)(Qs + rowl * 72 + sub * 4) = qw;
    }
    LDS_SYNC();
    const int tb = (w & 1) * 32, g = w >> 1, hq = hkv * 4 + g;
    const float sk = as_global(p->sinks)[l * 16 + hq];
    const int jlo = samp ? 0 : (128 - q0pos);
#pragma unroll 1
    for (int mt = 0; mt < 2; ++mt) {
        if (tb + mt * 16 >= nq) continue;
        const int rb = w * 32 + mt * 16;
        const bf16x8 qb0 = frag(Qs, rb, 72, 0, fr, fq), qb1 = frag(Qs, rb, 72, 32, fr, fq);
        f32x4 sacc[12];
        const int T0 = tb + mt * 16, n0 = T0 >> 4;
        const bool early = jlo > 0;
#pragma unroll
        for (int nt = 0; nt < 12; ++nt) { f32x4 z = {0.f, 0.f, 0.f, 0.f};
            if (nt >= n0 && nt <= n0 + 8) { z = MFMA16(frag(Ks, nt * 16, 72, 0, fr, fq), qb0, z); z = MFMA16(frag(Ks, nt * 16, 72, 32, fr, fq), qb1, z); }
            sacc[nt] = z; }
        const int t = T0 + fr; const int lo = (t + 1 > jlo) ? t + 1 : jlo; const unsigned span = (unsigned)(t + 128 - lo);
        float mx = -1e30f;
#pragma unroll
        for (int nt = 0; nt < 12; ++nt) { if (nt >= n0 && nt <= n0 + 8) {
#pragma unroll
                for (int i = 0; i < 4; ++i) { float sv = sacc[nt][i];
                    if (early || nt == n0 || nt == n0 + 8) { const int j = nt * 16 + 4 * fq + i; sv = ((unsigned)(j - lo) <= span) ? sv : -1e30f; sacc[nt][i] = sv; }
                    mx = fmaxf(mx, sv); } } }
        mx = fmaxf(mx, __shfl_xor(mx, 16)); mx = fmaxf(mx, __shfl_xor(mx, 32));
        mx = fmaxf(mx, sk); float sum = 0.f;
#pragma unroll
        for (int nt = 0; nt < 12; ++nt) { if (nt >= n0 && nt <= n0 + 8) {
#pragma unroll
                for (int i = 0; i < 4; ++i) { const float e = __expf(sacc[nt][i] - mx); sacc[nt][i] = e; sum += e; } } }
        sum += __shfl_xor(sum, 16); sum += __shfl_xor(sum, 32);
        const float inv = __builtin_amdgcn_rcpf(sum + __expf(sk - mx));
        f32x4 oacc[4];
#pragma unroll
        for (int dt = 0; dt < 4; ++dt) oacc[dt] = (f32x4){0.f, 0.f, 0.f, 0.f};
#pragma unroll
        for (int m = 0; m < 6; ++m) {
            if (2 * m + 1 >= n0 && 2 * m <= n0 + 8) {
                const f32x4 pa = sacc[2 * m] * inv, pc = sacc[2 * m + 1] * inv;
                const u32x4 pw = {pk2(pa[0], pa[1]), pk2(pa[2], pa[3]), pk2(pc[0], pc[1]), pk2(pc[2], pc[3])};
                const bf16x8 pb = __builtin_bit_cast(bf16x8, pw);
                const LAS bf16_t* va = Vt + (32 * m + fq * 4 + ((lane >> 2) & 3)) * 72 + 8 * (lane & 3);
#pragma unroll
                for (int dt = 0; dt < 4; ++dt) { const int co = 32 * (dt >> 1) + 4 * (dt & 1); const v4i16_t vl = __builtin_amdgcn_ds_read_tr16_b64_v4i16((LAS v4i16_t*)(va + co)), vh = __builtin_amdgcn_ds_read_tr16_b64_v4i16((LAS v4i16_t*)(va + 16 * 72 + co));
                    oacc[dt] = MFMA16(((bf16x8){vl[0], vl[1], vl[2], vl[3], vh[0], vh[1], vh[2], vh[3]}), pb, oacc[dt]); } } }
        if (t < nq) {
#pragma unroll
            for (int e = 0; e < 2; ++e) { const f32x4 o0 = oacc[2 * e], o1 = oacc[2 * e + 1]; u32x4 ow; ow.x = pk2(o0[0], o0[1]); ow.y = pk2(o0[2], o0[3]); ow.z = pk2(o1[0], o1[1]); ow.w = pk2(o1[2], o1[3]);
                *(u32x4*)(MIX + (size_t)(rowq0 + t) * D + hq * 64 + 32 * e + 8 * fq) = ow; } }
    }
    LDS_SYNC();
}

struct ChunkRaw { u32x2 a[4], b[4], c[4]; };
__device__ __forceinline__ void chunk_load(KP p, int mx, int it, int tid, ChunkRaw& r) {
    const bf16_t* P = (const bf16_t*)(as_global(p->ws) + WS_P);
    const bool samp = it >= 520; int h, nq, rowbase;
    if (!samp) { const int seq = it / 65, c = it - seq * 65; const int b = seq >> 2; h = seq & 3; const int q0 = c ? 16 + 64 * (c - 1) : 0; nq = c ? 64 : 16; rowbase = b * LP + q0; }
    else { const int s = it - 520; const int b = s >> 2; h = s & 3; nq = 4; rowbase = NPROMPT + b * 4; }
    const int c4 = (tid & 31) * 4, tr = tid >> 5, i2 = (tid & 31) * 2;
#pragma unroll
    for (int ps = 0; ps < 4; ++ps) { const int t = ps * 16 + tr; r.a[ps] = (u32x2){0u, 0u}; r.b[ps] = r.a[ps]; r.c[ps] = r.a[ps];
        if (t < nq) { const bf16_t* pr = P + (size_t)(rowbase + t) * DIN + h * 128;
            if (mx == 0) { r.a[ps] = *(const u32x2*)(pr + c4 + C_FB); r.b[ps] = *(const u32x2*)(pr + c4 + C_QB); r.c[ps] = *(const u32x2*)(pr + c4 + C_IB); }
            else { r.a[ps] = *(const u32x2*)(pr + C_VC + c4); r.b[ps].x = *(const unsigned*)(pr + C_QC + i2); r.b[ps].y = *(const unsigned*)(pr + C_QC + 64 + i2); r.c[ps].x = *(const unsigned*)(pr + C_KC + i2); r.c[ps].y = *(const unsigned*)(pr + C_KC + 64 + i2); } } }
}
__device__ __forceinline__ void chunk_item(KP p, int l, int mx, int it, int it_next, ChunkRaw& raw, LAS unsigned char* lds, int tid) {
    const int lane = tid & 63, w = tid >> 6, fr = lane & 15, fq = lane >> 4;
    LAS float* G = (LAS float*)lds;
    LAS bf16_t* Qt = (LAS bf16_t*)(lds + 32768);
    LAS bf16_t* Kt = (LAS bf16_t*)(lds + 50176);
    LAS bf16_t* Vt = (LAS bf16_t*)(lds + 67584);
    LAS bf16_t* Kst = (LAS bf16_t*)(lds + 86016);
    LAS bf16_t* As = (LAS bf16_t*)(lds + 104448);
    LAS float* TOT = (LAS float*)(lds + 113664);
    const bf16_t* P = (const bf16_t*)(as_global(p->ws) + WS_P);
    float* INTRA = (float*)(as_global(p->ws) + WS_INTRA); bf16_t* QI = (bf16_t*)(as_global(p->ws) + WS_QI); float* LS = (float*)(as_global(p->ws) + WS_LS); float* DEC = (float*)(as_global(p->ws) + WS_DEC);
    const bool samp = it >= 520;
    int h, nq, rowbase, pos0;
    if (!samp) { const int seq = it / 65, c = it - seq * 65; const int b = seq >> 2; h = seq & 3; const int q0 = c ? 16 + 64 * (c - 1) : 0; nq = c ? 64 : 16; rowbase = b * LP + q0; pos0 = q0; }
    else { const int s = it - 520; const int b = s >> 2; h = s & 3; nq = 4; rowbase = NPROMPT + b * 4; pos0 = PAST; }
    const int c4 = (tid & 31) * 4, tr = tid >> 5;
    const float lgh = LG[h];
    if (mx == 0) {
        u32x2 rf[4], rq[4], ri[4];
#pragma unroll
        for (int ps = 0; ps < 4; ++ps) { rf[ps] = raw.a[ps]; rq[ps] = raw.b[ps]; ri[ps] = raw.c[ps]; }
        if (it_next < NITEM) chunk_load(p, 0, it_next, tid, raw);
        float lbv[4];
#pragma unroll
        for (int e = 0; e < 4; ++e) { float v = 0.f; if (l == 1) { const float a0 = as_global(p->hgrn_lb)[h * 128 + c4 + e], a1 = as_global(p->hgrn_lb)[512 + h * 128 + c4 + e]; v = 1.f / (1.f + expf(a0 - a1)); } lbv[e] = v; }
        f32x4 lf[4], kk[4];
#pragma unroll
        for (int ps = 0; ps < 4; ++ps) { const int t = ps * 16 + tr; lf[ps] = (f32x4){0.f, 0.f, 0.f, 0.f}; kk[ps] = lf[ps];
            if (t < nq) { const float z[4] = {bf_lo(rf[ps].x), bf_hi(rf[ps].x), bf_lo(rf[ps].y), bf_hi(rf[ps].y)};
#pragma unroll
                for (int e = 0; e < 4; ++e) { const float ez = __expf(-fabsf(z[e])), rc = __builtin_amdgcn_rcpf(1.f + ez); const float sp = (z[e] >= 0.f) ? rc : ez * rc, sm = (z[e] >= 0.f) ? ez * rc : rc;
                    const float om = 1.f - lbv[e]; lf[ps][e] = __logf(fmaxf(lbv[e], 1e-30f) + om * sp); kk[ps][e] = om * sm; } }
            *(LAS f32x4*)(G + t * 128 + c4) = lf[ps]; }
        LDS_SYNC();
        { const int seg = tid >> 7, k = tid & 127; float r[16]; float run = 0.f;
#pragma unroll
          for (int i = 0; i < 16; ++i) { run += G[(seg * 16 + i) * 128 + k]; r[i] = run; }
          TOT[seg * 128 + k] = run;
          LDS_SYNC();
          float off = 0.f;
#pragma unroll
          for (int s2 = 0; s2 < 3; ++s2) off += (s2 < seg) ? TOT[s2 * 128 + k] : 0.f;
#pragma unroll
          for (int i = 0; i < 16; ++i) G[(seg * 16 + i) * 128 + k] = r[i] + off; }
        LDS_SYNC();
        const f32x4 gm = *(const LAS f32x4*)(G + 31 * 128 + c4), gl = *(const LAS f32x4*)(G + 63 * 128 + c4);
        const f32x4 egm = {__expf(gm[0]), __expf(gm[1]), __expf(gm[2]), __expf(gm[3])}, eglm = {__expf(gl[0] - gm[0]), __expf(gl[1] - gm[1]), __expf(gl[2] - gm[2]), __expf(gl[3] - gm[3])};
#pragma unroll
        for (int ps = 0; ps < 4; ++ps) { const int t = ps * 16 + tr; const bool valid = t < nq;
            const float zq[4] = {bf_lo(rq[ps].x), bf_hi(rq[ps].x), bf_lo(rq[ps].y), bf_hi(rq[ps].y)}; const u32x2 iv = ri[ps];
            const f32x4 gg = *(const LAS f32x4*)(G + t * 128 + c4);
            float qt[4], kt[4], qi[4], ks4[4];
#pragma unroll
            for (int e = 0; e < 4; ++e) { const float kv = kk[ps][e]; const float q = valid ? siluf(zq[e]) : 0.f;
                const float dg = fminf(fmaxf(gg[e] - gm[e], -80.f), 80.f); const float ep = __expf(dg), en = __builtin_amdgcn_rcpf(ep);
                qt[e] = q * ep; kt[e] = kv * en; qi[e] = qt[e] * egm[e];
                ks4[e] = kt[e] * eglm[e]; }
            u32x2 w2; w2.x = pk2(qt[0], qt[1]); w2.y = pk2(qt[2], qt[3]); *(LAS u32x2*)(Qt + t * 136 + c4) = w2;
            w2.x = pk2(kt[0], kt[1]); w2.y = pk2(kt[2], kt[3]); *(LAS u32x2*)(Kt + t * 136 + c4) = w2;
            w2.x = pk2(ks4[0], ks4[1]); w2.y = pk2(ks4[2], ks4[3]); *(LAS u32x2*)(Kst + t * 136 + c4) = w2;
            *(LAS u32x2*)(Vt + t * 136 + c4) = iv;
            if (valid) { w2.x = pk2(qi[0], qi[1]); w2.y = pk2(qi[2], qi[3]); *(u32x2*)(QI + (size_t)(rowbase + t) * 1024 + h * 128 + c4) = w2; }
            if (t == 63) *(f32x4*)(DEC + (size_t)it * 128 + c4) = (f32x4){__expf(gl[0]), __expf(gl[1]), __expf(gl[2]), __expf(gl[3])}; }
    } else {
        const int i2 = (tid & 31) * 2;
        unsigned ra[4], rb[4], rc[4], rd[4]; u32x2 ri[4];
#pragma unroll
        for (int ps = 0; ps < 4; ++ps) { ri[ps] = raw.a[ps]; ra[ps] = raw.b[ps].x; rb[ps] = raw.b[ps].y; rc[ps] = raw.c[ps].x; rd[ps] = raw.c[ps].y; }
        if (it_next < NITEM) chunk_load(p, 1, it_next, tid, raw);
#pragma unroll
        for (int ps = 0; ps < 4; ++ps) { const int t = ps * 16 + tr; const bool valid = t < nq;
            const float q1[2] = {bf_lo(ra[ps]), bf_hi(ra[ps])}, q2[2] = {bf_lo(rb[ps]), bf_hi(rb[ps])}, k1[2] = {bf_lo(rc[ps]), bf_hi(rc[ps])}, k2[2] = {bf_lo(rd[ps]), bf_hi(rd[ps])}; const u32x2 iv = ri[ps];
            const float tail = valid ? __expf(lgh * (float)(nq - 1 - t)) : 0.f;
            float qa[2], qb[2], ka[2], kb[2];
#pragma unroll
            for (int e = 0; e < 2; ++e) { float s, c; sincos_red((float)(pos0 + t) * INV_C[i2 + e], s, c);
                qa[e] = q1[e] * c - q2[e] * s; qb[e] = q2[e] * c + q1[e] * s; ka[e] = (k1[e] * c - k2[e] * s) * 0.08838834764831845f; kb[e] = (k2[e] * c + k1[e] * s) * 0.08838834764831845f;
                }
            const unsigned qlo = pk2(qa[0], qa[1]), qhi = pk2(qb[0], qb[1]);
            *(LAS unsigned*)(Qt + t * 136 + i2) = qlo; *(LAS unsigned*)(Qt + t * 136 + 64 + i2) = qhi;
            *(LAS unsigned*)(Kt + t * 136 + i2) = pk2(ka[0], ka[1]); *(LAS unsigned*)(Kt + t * 136 + 64 + i2) = pk2(kb[0], kb[1]);
            *(LAS unsigned*)(Kst + t * 136 + i2) = pk2(ka[0] * tail, ka[1] * tail); *(LAS unsigned*)(Kst + t * 136 + 64 + i2) = pk2(kb[0] * tail, kb[1] * tail);
            *(LAS u32x2*)(Vt + t * 136 + c4) = iv;
            if (valid) { bf16_t* qr = QI + (size_t)(rowbase + t) * 1024 + 512 + h * 128; *(unsigned*)(qr + i2) = qlo; *(unsigned*)(qr + 64 + i2) = qhi; } }
    }
    LDS_SYNC();
    const int colo = mx * 512 + h * 128;
    if ((w >> 1) * 16 < nq) { const int qt = w >> 1, vh = w & 1, q = qt * 16 + fr;
      f32x4 at[4];
#pragma unroll
      for (int st = 0; st < 4; ++st) { f32x4 z = {0.f, 0.f, 0.f, 0.f};
          if (st <= qt) {
#pragma unroll
              for (int ks = 0; ks < 4; ++ks) z = MFMA16(frag(Kt, st * 16, 136, ks * 32, fr, fq), frag(Qt, qt * 16, 136, ks * 32, fr, fq), z);
#pragma unroll
              for (int i = 0; i < 4; ++i) { const int sI = st * 16 + 4 * fq + i; float v = (sI <= q) ? z[i] : 0.f; if (mx == 1) v *= __expf(lgh * (float)((sI <= q) ? (q - sI) : 0)); z[i] = v; } }
          at[st] = z; }
#pragma unroll
      for (int e = 0; e < 2; ++e) { const int vp = vh * 2 + e; f32x4 acc0 = {0.f, 0.f, 0.f, 0.f}, acc1 = {0.f, 0.f, 0.f, 0.f};
#pragma unroll
          for (int m = 0; m < 2; ++m) { if (2 * m <= qt) {
                  const u32x4 pw = {pk2(at[2 * m][0], at[2 * m][1]), pk2(at[2 * m][2], at[2 * m][3]), pk2(at[2 * m + 1][0], at[2 * m + 1][1]), pk2(at[2 * m + 1][2], at[2 * m + 1][3])};
                  const bf16x8 pb = __builtin_bit_cast(bf16x8, pw);
                  const LAS bf16_t* va = Vt + (32 * m + fq * 4 + ((lane >> 2) & 3)) * 136 + 32 * vp + 8 * (lane & 3);
                  const v4i16_t l0 = __builtin_amdgcn_ds_read_tr16_b64_v4i16((LAS v4i16_t*)va), h0 = __builtin_amdgcn_ds_read_tr16_b64_v4i16((LAS v4i16_t*)(va + 16 * 136));
                  const v4i16_t l1 = __builtin_amdgcn_ds_read_tr16_b64_v4i16((LAS v4i16_t*)(va + 4)), h1 = __builtin_amdgcn_ds_read_tr16_b64_v4i16((LAS v4i16_t*)(va + 16 * 136 + 4));
                  acc0 = MFMA16(((bf16x8){l0[0], l0[1], l0[2], l0[3], h0[0], h0[1], h0[2], h0[3]}), pb, acc0);
                  acc1 = MFMA16(((bf16x8){l1[0], l1[1], l1[2], l1[3], h1[0], h1[1], h1[2], h1[3]}), pb, acc1); } }
          if (q < nq) { u32x4 iw; iw.x = pk2(acc0[0], acc0[1]); iw.y = pk2(acc0[2], acc0[3]); iw.z = pk2(acc1[0], acc1[1]); iw.w = pk2(acc1[2], acc1[3]);
              *(u32x4*)((bf16_t*)INTRA + (size_t)(rowbase + q) * 1024 + colo + 32 * vp + 8 * fq) = iw; } } }
    bf16_t* ls = (bf16_t*)LS + ((size_t)mx * NITEM + it) * 16384;
#pragma unroll
    for (int vp = 0; vp < 4; ++vp) { f32x4 acc0 = {0.f, 0.f, 0.f, 0.f}, acc1 = {0.f, 0.f, 0.f, 0.f};
#pragma unroll
        for (int ks = 0; ks < 2; ++ks) { const bf16x8 kf = frag_tr(Kst, 136, ks * 32, w * 16, lane);
            const LAS bf16_t* va = Vt + (ks * 32 + (lane >> 4) * 8 + ((lane >> 2) & 3)) * 136 + 32 * vp + 8 * (lane & 3);
            const v4i16_t l0 = __builtin_amdgcn_ds_read_tr16_b64_v4i16((LAS v4i16_t*)va), h0 = __builtin_amdgcn_ds_read_tr16_b64_v4i16((LAS v4i16_t*)(va + 4 * 136));
            const v4i16_t l1 = __builtin_amdgcn_ds_read_tr16_b64_v4i16((LAS v4i16_t*)(va + 4)), h1 = __builtin_amdgcn_ds_read_tr16_b64_v4i16((LAS v4i16_t*)(va + 4 * 136 + 4));
            acc0 = MFMA16(((bf16x8){l0[0], l0[1], l0[2], l0[3], h0[0], h0[1], h0[2], h0[3]}), kf, acc0);
            acc1 = MFMA16(((bf16x8){l1[0], l1[1], l1[2], l1[3], h1[0], h1[1], h1[2], h1[3]}), kf, acc1); }
        u32x4 lw; lw.x = pk2(acc0[0], acc0[1]); lw.y = pk2(acc0[2], acc0[3]); lw.z = pk2(acc1[0], acc1[1]); lw.w = pk2(acc1[2], acc1[3]);
        *(u32x4*)(ls + (w * 16 + fr) * 128 + 32 * vp + 8 * fq) = lw; }
    LDS_SYNC();
}

struct FinRaw { u32x2 sw[8]; u32x4 qv[2]; u32x2 iv[4]; u32x4 g0, g1; };
__device__ __forceinline__ FinRaw finish_load(KP p, int l, int mx, int it, int tid) { FinRaw r;
    const int lane = tid & 63, w = tid >> 6, fr = lane & 15, fq = lane >> 4;
    const bf16_t* P = (const bf16_t*)(as_global(p->ws) + WS_P);
    const bf16_t* INTRA = (const bf16_t*)(as_global(p->ws) + WS_INTRA); const bf16_t* QI = (const bf16_t*)(as_global(p->ws) + WS_QI); const bf16_t* LSb = (const bf16_t*)(as_global(p->ws) + WS_LS);
    const bool samp = it >= 520;
    int h, nq, rowbase; const float* S = nullptr; const bf16_t* Sb = nullptr;
    if (!samp) { const int seq = it / 65, c = it - seq * 65; const int b = seq >> 2; h = seq & 3; const int q0 = c ? 16 + 64 * (c - 1) : 0; nq = c ? 64 : 16; rowbase = b * LP + q0;
        if (c) Sb = LSb + ((size_t)mx * NITEM + it - 1) * 16384; }
    else { const int s = it - 520; const int b = s >> 2; h = s & 3; nq = 4; rowbase = NPROMPT + b * 4; S = (mx ? as_global(p->state_ret) : as_global(p->state_hgrn)) + ((size_t)((l * 32 + b) * 4 + h)) * 16384; }
    const int colo = mx * 512 + h * 128;
    const int v4 = (tid & 31) * 4, kr = tid >> 5;
#pragma unroll
    for (int ps = 0; ps < 8; ++ps) { r.sw[ps] = (u32x2){0u, 0u};
        if (Sb) r.sw[ps] = *(const u32x2*)(Sb + (ps * 16 + kr) * 128 + v4);
        else if (S) { const f32x4 f = *(const f32x4*)(S + (ps * 16 + kr) * 128 + v4); r.sw[ps].x = pk2(f[0], f[1]); r.sw[ps].y = pk2(f[2], f[3]); } }
#pragma unroll
    for (int q = 0; q < 2; ++q) { const int idx = tid + q * 512, t = idx >> 4, ch = idx & 15; r.qv[q] = (u32x4){0u, 0u, 0u, 0u}; if (t < nq) r.qv[q] = *(const u32x4*)(QI + (size_t)(rowbase + t) * 1024 + colo + ch * 8); }
#pragma unroll
    for (int tt = 0; tt < 4; ++tt) { const int t = tt * 16 + fr; r.iv[tt] = (u32x2){0u, 0u}; if (t < nq) r.iv[tt] = *(const u32x2*)(INTRA + (size_t)(rowbase + t) * 1024 + colo + w * 16 + 4 * fq); }
    const int t8 = tid >> 3, part = tid & 7; r.g0 = (u32x4){0u, 0u, 0u, 0u}; r.g1 = r.g0;
    if (t8 < nq) { const bf16_t* gp = P + (size_t)(rowbase + t8) * DIN + (mx ? C_GC : C_GB) + h * 128 + part * 16; r.g0 = *(const u32x4*)gp; r.g1 = *(const u32x4*)(gp + 8); }
    return r;
}
__device__ __forceinline__ void finish_item(KP p, int l, int mx, int it, int it_next, int mx_next, FinRaw& raw, LAS unsigned char* lds, int tid) {
    const int lane = tid & 63, w = tid >> 6, fr = lane & 15, fq = lane >> 4;
    LAS bf16_t* St = (LAS bf16_t*)lds;
    LAS bf16_t* Qi = (LAS bf16_t*)(lds + 34816);
    LAS float* Ob = (LAS float*)(lds + 52224);
    const bf16_t* P = (const bf16_t*)(as_global(p->ws) + WS_P);
    const float* INTRA = (const float*)(as_global(p->ws) + WS_INTRA); const bf16_t* QI = (const bf16_t*)(as_global(p->ws) + WS_QI); const float* LS = (const float*)(as_global(p->ws) + WS_LS);
    bf16_t* MIX = (bf16_t*)(as_global(p->ws) + WS_ACT);
    const bool samp = it >= 520;
    int h, nq, rowbase; const float* S = nullptr; const bf16_t* Sb = nullptr;
    if (!samp) { const int seq = it / 65, c = it - seq * 65; const int b = seq >> 2; h = seq & 3; const int q0 = c ? 16 + 64 * (c - 1) : 0; nq = c ? 64 : 16; rowbase = b * LP + q0;
        if (c) Sb = (const bf16_t*)LS + ((size_t)mx * NITEM + it - 1) * 16384; }
    else { const int s = it - 520; const int b = s >> 2; h = s & 3; nq = 4; rowbase = NPROMPT + b * 4; S = (mx ? as_global(p->state_ret) : as_global(p->state_hgrn)) + ((size_t)((l * 32 + b) * 4 + h)) * 16384; }
    const int colo = mx * 512 + h * 128;
    const int v4 = (tid & 31) * 4, kr = tid >> 5;
    u32x2 sw[8]; u32x4 qv[2]; f32x4 iv[4]; u32x4 g0, g1;
#pragma unroll
    for (int ps = 0; ps < 8; ++ps) sw[ps] = raw.sw[ps];
    qv[0] = raw.qv[0]; qv[1] = raw.qv[1]; g0 = raw.g0; g1 = raw.g1;
#pragma unroll
    for (int tt = 0; tt < 4; ++tt) iv[tt] = (f32x4){bf_lo(raw.iv[tt].x), bf_hi(raw.iv[tt].x), bf_lo(raw.iv[tt].y), bf_hi(raw.iv[tt].y)};
    if (it_next >= 0) { int tid2 = tid; asm volatile("" : "+v"(tid2)); raw = finish_load(p, l, mx_next, it_next, tid2); }
    const int t8 = tid >> 3, part = tid & 7;
#pragma unroll
    for (int ps = 0; ps < 8; ++ps) { const int k = ps * 16 + kr; *(LAS u32x2*)(St + k * 136 + v4) = sw[ps]; }
#pragma unroll
    for (int r = 0; r < 2; ++r) { const int idx = tid + r * 512, t = idx >> 4, ch = idx & 15; *(LAS u32x4*)(Qi + t * 136 + ch * 8) = qv[r]; }
    LDS_SYNC();
    const float lgh = LG[h];
#pragma unroll
    for (int tt = 0; tt < 4; ++tt) { f32x4 acc = {0.f, 0.f, 0.f, 0.f};
#pragma unroll
        for (int ks = 0; ks < 4; ++ks) acc = MFMA16(frag_tr(St, 136, ks * 32, w * 16, lane), frag(Qi, tt * 16, 136, ks * 32, fr, fq), acc);
        const int t = tt * 16 + fr;
        if (mx == 1) acc = acc * __expf(lgh * (float)(t + 1));
        acc = acc + iv[tt];
        *(LAS f32x4*)(Ob + t * 132 + w * 16 + 4 * fq) = acc; }
    LDS_SYNC();
    { const int t = t8; const LAS float* orow = Ob + t * 132 + part * 16; float o[16]; float ss = 0.f;
#pragma unroll
      for (int j = 0; j < 4; ++j) { const f32x4 v = *(const LAS f32x4*)(orow + 4 * j); o[4 * j] = v[0]; o[4 * j + 1] = v[1]; o[4 * j + 2] = v[2]; o[4 * j + 3] = v[3]; ss += (v[0] * v[0] + v[1] * v[1]) + (v[2] * v[2] + v[3] * v[3]); }
      ss += __shfl_xor(ss, 1); ss += __shfl_xor(ss, 2); ss += __shfl_xor(ss, 4);
      if (t < nq) { const float r = rsqrtf(ss * (1.f / 128.f) + EPS); const float* nw = (mx ? as_global(p->ret_norm) : as_global(p->hgrn_norm)) + l * 128 + part * 16;
          const unsigned gw[8] = {g0.x, g0.y, g0.z, g0.w, g1.x, g1.y, g1.z, g1.w}; unsigned ow[8];
#pragma unroll
          for (int j = 0; j < 8; ++j) { const float a = o[2 * j] * r * nw[2 * j] * siluf(bf_lo(gw[j])), b2 = o[2 * j + 1] * r * nw[2 * j + 1] * siluf(bf_hi(gw[j])); ow[j] = pk2(a, b2); }
          bf16_t* mp = MIX + (size_t)(rowbase + t) * D + 1024 + colo + part * 16;
          *(u32x4*)mp = (u32x4){ow[0], ow[1], ow[2], ow[3]}; *(u32x4*)(mp + 8) = (u32x4){ow[4], ow[5], ow[6], ow[7]}; } }
    LDS_SYNC();
}

__device__ __forceinline__ void scan_phase(KP p, int l, int tid) {
    bf16_t* LS = (bf16_t*)(as_global(p->ws) + WS_LS); const float* DEC = (const float*)(as_global(p->ws) + WS_DEC);
#define LDB4(ptr) ({ const u32x2 _u = *(const u32x2*)(ptr); (f32x4){bf_lo(_u.x), bf_hi(_u.x), bf_lo(_u.y), bf_hi(_u.y)}; })
    const int gid = blockIdx.x * 512 + tid, gsz = gridDim.x * 512;
    for (int idx = gid; idx < 131072; idx += gsz) { const int mx = idx >> 16, seq = (idx >> 13) & 7, e2 = idx & 8191, k = e2 >> 6, h = seq & 3, b = seq >> 2;
        float s0 = 0.f, s1 = 0.f; bf16_t* base = LS + ((size_t)mx * NITEM + seq * 65) * 16384 + e2 * 2; const float* dp = DEC + (size_t)(seq * 65) * 128 + k;
        const float d16 = __expf(LG[h] * 16.f), d64 = __expf(LG[h] * 64.f);
        unsigned ls[13], ln[13]; float dd[13], dn[13];
#pragma unroll
        for (int j = 0; j < 13; ++j) { ls[j] = *(const unsigned*)(base + (size_t)j * 16384); dd[j] = mx ? (j ? d64 : d16) : dp[j * 128]; }
#pragma unroll 1
        for (int g5 = 0; g5 < 5; ++g5) {
            if (g5 < 4) {
#pragma unroll
                for (int j = 0; j < 13; ++j) { const int c = (g5 + 1) * 13 + j; ln[j] = *(const unsigned*)(base + (size_t)c * 16384); dn[j] = mx ? d64 : dp[c * 128]; } }
#pragma unroll
            for (int j = 0; j < 13; ++j) { const int c = g5 * 13 + j; s0 = s0 * dd[j] + bf_lo(ls[j]); s1 = s1 * dd[j] + bf_hi(ls[j]); *(unsigned*)(base + (size_t)c * 16384) = pk2(s0, s1); }
#pragma unroll
            for (int j = 0; j < 13; ++j) { ls[j] = ln[j]; dd[j] = dn[j]; }
        }
        float* o = as_global(p->out) + (mx ? O_SRP : O_SHP) + ((size_t)((l * 2 + b) * 4 + h)) * 16384 + e2 * 2; o[0] = s0; o[1] = s1; }
    for (int idx = gid; idx < 2 * 128 * 4096; idx += gsz) { const int mx = idx >> 19, s_ = (idx >> 12) & 127, e4 = idx & 4095, k = e4 >> 5, b = s_ >> 2, h = s_ & 3, it = 520 + s_;
        const size_t so = ((size_t)((l * 32 + b) * 4 + h)) * 16384 + e4 * 4;
        const f32x4 s0 = *(const f32x4*)((mx ? as_global(p->state_ret) : as_global(p->state_hgrn)) + so); const f32x4 ls = LDB4(LS + ((size_t)mx * NITEM + it) * 16384 + e4 * 4);
        const float d = mx ? __expf(LG[h] * 4.f) : DEC[(size_t)it * 128 + k];
        *(f32x4*)(as_global(p->out) + (mx ? O_SRS : O_SHS) + so) = s0 * d + ls; }
#undef LDB4
}

#define XB_TMO      128
#define XB_XCNT(j)  (256  + 64 * (j))
#define XB_XSUB(j)  (1280 + 64 * (j))
#define XB_XGEN(j)  (2304 + 64 * (j))
#define XB_TOP      3328
#define XB_TOPGEN   3392
#define XCD_BAR_WORDS 3456
#define XB_SPIN_CAP (1u << 18)
__device__ __forceinline__ unsigned xb_ld(unsigned* p)              { return __hip_atomic_load(p, __ATOMIC_RELAXED, __HIP_MEMORY_SCOPE_AGENT); }
__device__ __forceinline__ unsigned xb_add(unsigned* p, unsigned v) { return __hip_atomic_fetch_add(p, v, __ATOMIC_RELAXED, __HIP_MEMORY_SCOPE_AGENT); }
__device__ __forceinline__ unsigned xb_xcc_id() { return (unsigned)__builtin_amdgcn_s_getreg((3 << 11) | 20) & 0xFu; }
#define XB_SPIN(cond, bar) do { unsigned _sp = 0; while (cond) { __builtin_amdgcn_s_sleep(1); \
    if ((++_sp & 255u) == 0u) { if (xb_ld(&(bar)[XB_TMO])) break; if (_sp > XB_SPIN_CAP) { atomicAdd(&(bar)[XB_TMO], 1u); break; } } } } while (0)
struct XcdBarrier { unsigned* bar; unsigned x; volatile LAS unsigned* st; };
__device__ __forceinline__ XcdBarrier xcd_barrier_post(unsigned* bar, volatile LAS unsigned* st) {
    XcdBarrier b; b.bar = bar; b.x = xb_xcc_id(); b.st = st;
    if (threadIdx.x == 0) (void)xb_add(&bar[XB_XCNT(b.x)], 1u);
    return b;
}
__device__ __forceinline__ void xcd_barrier_complete(unsigned* bar, unsigned x, unsigned& nloc, unsigned& nx) {
    const unsigned G = gridDim.x * gridDim.y * gridDim.z;
    unsigned sum, cnt, mine, sp = 0u;
    for (;;) {
        sum = 0u; cnt = 0u; mine = 0u;
#pragma unroll
        for (unsigned j = 0; j < 16; ++j) { const unsigned c = xb_ld(&bar[XB_XCNT(j)]); sum += c; cnt += (c > 0u) ? 1u : 0u; mine = (j == x) ? c : mine; }
        if (sum == G) break;
        __builtin_amdgcn_s_sleep(1);
        if ((++sp & 255u) == 0u) { if (xb_ld(&bar[XB_TMO])) break; if (sp > XB_SPIN_CAP) { atomicAdd(&bar[XB_TMO], 1u); break; } }
    }
    nloc = mine > 0u ? mine : 1u; nx = cnt > 0u ? cnt : 1u;
}
__device__ __forceinline__ void xcd_barrier(const XcdBarrier& b, const int tid) {
    asm volatile("s_waitcnt vmcnt(0)" ::: "memory");
    __syncthreads();
    if (tid == 0) {
        unsigned* bar = b.bar;
        __builtin_amdgcn_s_waitcnt(0);
        unsigned nloc = b.st[0], nx = b.st[1];
        if (nloc == 0u) { xcd_barrier_complete(bar, b.x, nloc, nx); b.st[0] = nloc; b.st[1] = nx; }
        const unsigned old = xb_add(&bar[XB_XSUB(b.x)], 1u);
        const unsigned gen = old / nloc;
        if (old + 1u == (gen + 1u) * nloc) {
            __builtin_amdgcn_fence(__ATOMIC_RELEASE, "agent");
            asm volatile("s_waitcnt vmcnt(0)" ::: "memory");
            const unsigned og = xb_add(&bar[XB_TOP], 1u);
            const unsigned tg = og / nx;
            if (og + 1u == (tg + 1u) * nx) xb_add(&bar[XB_TOPGEN], 1u);
            else XB_SPIN(xb_ld(&bar[XB_TOPGEN]) == tg, bar);
            __builtin_amdgcn_fence(__ATOMIC_ACQUIRE, "agent");
            xb_add(&bar[XB_XGEN(b.x)], 1u);
            asm volatile("s_waitcnt vmcnt(0)" ::: "memory");
        } else {
            XB_SPIN(xb_ld(&bar[XB_XGEN(b.x)]) == gen, bar);
            __builtin_amdgcn_fence(__ATOMIC_ACQUIRE, "agent");
            asm volatile("s_waitcnt vmcnt(0)" ::: "memory");
        }
    }
    __syncthreads();
}

__global__ void __launch_bounds__(512, 2) hymba_fwd(Params p_arg) {
    KP p = (KP)__builtin_amdgcn_kernarg_segment_ptr();
    extern __shared__ __attribute__((aligned(16))) unsigned char lds_raw[];
    LAS unsigned char* lds = (LAS unsigned char*)lds_raw;
    cg::grid_group grid = cg::this_grid();
    volatile LAS unsigned* bst = (volatile LAS unsigned*)(lds + 147392);
    if (threadIdx.x < 2) bst[threadIdx.x] = 0u;
    const int wave_s = __builtin_amdgcn_readfirstlane(threadIdx.x >> 6);
    __syncthreads();
    const XcdBarrier xbar = xcd_barrier_post((unsigned*)(as_global(p->ws) + WS_CTL) + p->li * XCD_BAR_WORDS, bst);
    const int G = gridDim.x, bx = blockIdx.x;
    const int ph_lo = p->ph_lo, ph_hi = p->ph_hi;
    if (ph_lo < 0) grid.sync();
    KP p0 = p;
#pragma unroll 1
    for (int ph = ph_lo; ph < ph_hi; ++ph) {
        KP p = p0; asm volatile("" : "+s"(p));
        const int l = ph / 9, kind = ph - l * 9;
        int tid = wave_s * 64 + (int)__builtin_amdgcn_mbcnt_hi(~0u, __builtin_amdgcn_mbcnt_lo(~0u, 0u)); asm volatile("" : "+v"(tid));
        const int lane = tid & 63, wave = __builtin_amdgcn_readfirstlane(tid >> 6);
        unsigned char* wsb0 = p->ws; asm volatile("" : "+s"(wsb0)); unsigned char* wsb = as_global(wsb0);
        bf16_t* WT_IN = (bf16_t*)(wsb + (l ? WS_WIN2 : WS_WIN)); bf16_t* WT_OUT = (bf16_t*)(wsb + (l ? WS_WOUT2 : WS_WOUT)); bf16_t* WT_GU = (bf16_t*)(wsb + WS_WGU); bf16_t* WT_D = (bf16_t*)(wsb + (l ? WS_WD2 : WS_WD));
        const int remG1 = (33 * 22) % G, remG3 = (33 * 44) % G;
        float* X = (float*)(wsb + WS_X); bf16_t* ACT = (bf16_t*)(wsb + WS_ACT); bf16_t* Pb = (bf16_t*)(wsb + WS_P);
        if (ph == 18) {
            const int gid = bx * 512 + tid, gsz = G * 512;
            for (int idx = gid; idx < 160 * 512; idx += gsz) { const int row = 8192 + (idx >> 9), c4 = (idx & 511) * 4; f32x4 v = *(const f32x4*)(X + (size_t)row * D + c4);
                f32x4 t[11];
#pragma unroll
                for (int kp = 0; kp < 11; ++kp) t[kp] = *(const f32x4*)((const float*)(wsb + WS_LS) + ((size_t)kp * 160 + (row - 8192)) * D + c4);
#pragma unroll
                for (int kp = 0; kp < 11; ++kp) v = v + t[kp];
                float* o = (row < NPROMPT) ? as_global(p->out) + O_YP + ((size_t)(4096 + row - LP - 16)) * D + c4 : as_global(p->out) + O_YS + (size_t)(row - NPROMPT) * D + c4; *(f32x4*)o = v; }
        } else if (kind == 0) {
            LAS float* scr = (LAS float*)(lds + wave * 18432);
            const int gw = bx * 8 + wave, NGW = G * 8;
            constexpr int I_IN = 32 * 88, I_OUT = 32 * 32, I_G = 32 * 88, I_D = 88 * 32, NIT = I_IN + I_OUT + 2 * I_G + I_D;
            const bool skip_i = (l == 1) && remG1 != 0, skip_od = (l == 1) && remG3 != 0, skip_g = (l == 1) && G > 88, skip_d0 = (l == 0) && G > 32;
            for (int it = gw; it < NIT; it += NGW) { int r = it;
                if (r < I_IN) { if (!skip_i) transpose_item(as_global(p->w_in) + (size_t)l * D * DIN, D, DIN, WT_IN, 3, scr, r, lane); continue; } r -= I_IN;
                if (r < I_OUT) { if (!skip_od) transpose_item(as_global(p->w_out) + (size_t)l * D * D, D, D, WT_OUT, 0, scr, r, lane); continue; } r -= I_OUT;
                if (r < I_G) { if (!skip_g) transpose_item(as_global(p->w_gate) + (size_t)l * D * DFF, D, DFF, WT_GU, 1, scr, r, lane); continue; } r -= I_G;
                if (r < I_G) { transpose_item(as_global(p->w_up) + (size_t)l * D * DFF, D, DFF, WT_GU, 2, scr, r, lane); continue; } r -= I_G;
                if (!skip_od && !skip_d0) transpose_item(as_global(p->w_down) + (size_t)l * DFF * D, DFF, D, WT_D, 0, scr, r, lane); }
#define SRC_ROW(m) ((l == 0) ? (((m) < NPROMPT) ? ((((m) % LP) < 16) ? as_global(p->meta) + (size_t)((m) % LP) * D : as_global(p->x_prompt) + ((size_t)((m) / LP) * 4096 + ((m) % LP) - 16) * D) : (((m) < NTOK) ? as_global(p->x_sample) + (size_t)((m) - NPROMPT) * D : (const float*)nullptr)) : (const float*)(X + (size_t)(m) * D))
            for (int m = gw; m + NGW < 8192 + NGW && m < 8192; m += 2 * NGW) { const int m1 = m + NGW;
                if (m1 < 8192) norm_row2(SRC_ROW(m), SRC_ROW(m1), as_global(p->norm_mix) + l * D, ACT + (size_t)m * D, ACT + (size_t)m1 * D, nullptr, nullptr, lane);
                else norm_row(SRC_ROW(m), as_global(p->norm_mix) + l * D, ACT + (size_t)m * D, nullptr, lane, nullptr, 0); }
            for (int m = 8192 + gw; m < MP; m += NGW) { const float* src = SRC_ROW(m); float* xc = (l == 0) ? X + (size_t)m * D : nullptr;
                const bool tl = (l == 1) && m < NTOK;
                norm_row(src, as_global(p->norm_mix) + l * D, ACT + (size_t)m * D, tl ? X + (size_t)m * D : xc, lane, (const float*)(wsb + WS_LS) + (size_t)(tl ? m - 8192 : 0) * D, tl ? 11 : 0); }
#undef SRC_ROW
        } else if (kind == 1) {
            pg8::Gemm g{ACT, WT_IN, MP, DIN, D}; pg8::StaticOrder S; S.init(MP, DIN, D, G, bx, false); pg8::EpiBf16 E{Pb, DIN};
#ifndef NO_G1
            pg8::gemm_phase<pg8::EpiBf16>(lds, g, S, E, tid);
#endif
            if (l == 0 && remG1 != 0 && bx >= remG1) {
                LAS float* scr = (LAS float*)(lds + wave * 18432);
                for (int it = (bx - remG1) * 8 + wave; it < 32 * 88; it += (G - remG1) * 8) transpose_item(as_global(p->w_in) + (size_t)D * DIN, D, DIN, (bf16_t*)(wsb + WS_WIN2), 3, scr, it, lane); }
        } else if (kind == 2) {
#ifndef NO_ATTN
#pragma unroll 1
            for (int it = bx; it < NITEM; it += G) attn_item(p, l, it, lds, tid);
#endif
#ifndef NO_CHUNK
            { ChunkRaw raw; int it = (bx + G - (136 % G)) % G; chunk_load(p, 0, it < NITEM ? it : 0, tid, raw);
#pragma unroll 1
              for (; it < NITEM; it += G) chunk_item(p, l, 0, it, it + G, raw, lds, tid); }
            { ChunkRaw raw; int it = (bx + 2 * G - (272 % G)) % G; chunk_load(p, 1, it < NITEM ? it : 0, tid, raw);
#pragma unroll 1
              for (; it < NITEM; it += G) chunk_item(p, l, 1, it, it + G, raw, lds, tid); }
#endif
        } else if (kind == 3) {
#ifndef NO_SCAN
            scan_phase(p, l, tid);
#endif
        } else if (kind == 4) {
#ifndef NO_FIN
            { FinRaw raw = finish_load(p, l, bx < NITEM ? 0 : 1, bx < NITEM ? bx : bx - NITEM, tid); int it = bx;
#pragma unroll 1
              for (; it < 2 * NITEM; it += G) { const int nx = it + G; const bool hn = nx < 2 * NITEM; const int mxn = (nx < NITEM) ? 0 : 1, itn = hn ? (nx < NITEM ? nx : nx - NITEM) : -1;
                  finish_item(p, l, (it < NITEM) ? 0 : 1, (it < NITEM) ? it : it - NITEM, itn, mxn, raw, lds, tid); } }
#endif
        } else if (kind == 5 || kind == 8) {
            const int Kd = kind == 5 ? D : DFF;
            pg8::Gemm g{kind == 5 ? ACT : Pb, kind == 5 ? WT_OUT : WT_D, MP, D, Kd}; pg8::StaticOrder S; S.init(MP, D, Kd, G, bx, true);
            pg8::EpiResid E{p->dummy ? (float*)(wsb + WS_LS) + (size_t)16 * 160 * D : X, (kind == 8 && l == 1) ? as_global(p->out) : nullptr, Kd / 64, (float*)(wsb + WS_LS), as_global(p->meta), (kind == 5 && l == 0 && !p->dummy) ? as_global(p->x_prompt) : nullptr};
#ifndef NO_G24
            pg8::gemm_phase<pg8::EpiResid>(lds, g, S, E, tid);
#endif
            if (kind == 5 && l == 0 && G > 32 && bx >= 32) {
                LAS float* scr = (LAS float*)(lds + wave * 18432);
                for (int it = (bx - 32) * 8 + wave; it < 88 * 32; it += (G - 32) * 8) transpose_item(as_global(p->w_down), DFF, D, (bf16_t*)(wsb + WS_WD), 0, scr, it, lane); }
            if (kind == 8 && l == 0 && G > 88 && bx >= 88) {
                LAS float* scr = (LAS float*)(lds + wave * 18432);
                for (int it = (bx - 88) * 8 + wave; it < 32 * 88; it += (G - 88) * 8) transpose_item(as_global(p->w_gate) + (size_t)D * DFF, D, DFF, WT_GU, 1, scr, it, lane); }
        } else if (kind == 6) {
            const int gw = bx * 8 + wave, NGW = G * 8;
            for (int m = gw; m < 8192; m += 2 * NGW) { const int m1 = m + NGW;
                if (m1 < 8192) norm_row2(X + (size_t)m * D, X + (size_t)m1 * D, as_global(p->norm_ffn) + l * D, ACT + (size_t)m * D, ACT + (size_t)m1 * D, nullptr, nullptr, lane);
                else norm_row(X + (size_t)m * D, as_global(p->norm_ffn) + l * D, ACT + (size_t)m * D, nullptr, lane, nullptr, 0); }
            for (int m = 8192 + gw; m < MP; m += NGW) { const bool tl = m < NTOK;
                norm_row(m < NTOK ? X + (size_t)m * D : nullptr, as_global(p->norm_ffn) + l * D, ACT + (size_t)m * D, tl ? X + (size_t)m * D : nullptr, lane, (const float*)(wsb + WS_LS) + (size_t)(tl ? m - 8192 : 0) * D, tl ? 4 : 0); }
        } else {
            pg8::Gemm g{ACT, WT_GU, MP, 2 * DFF, D}; pg8::StaticOrder S; S.init(MP, 2 * DFF, D, G, bx, false); pg8::EpiSwiglu E{Pb};
#ifndef NO_G3
            pg8::gemm_phase<pg8::EpiSwiglu>(lds, g, S, E, tid);
#endif
            if (l == 0 && remG3 != 0 && bx >= remG3) {
                LAS float* scr = (LAS float*)(lds + wave * 18432);
                for (int it = (bx - remG3) * 8 + wave; it < 32 * 32 + 88 * 32; it += (G - remG3) * 8) {
                    if (it < 32 * 32) transpose_item(as_global(p->w_out) + (size_t)D * D, D, D, (bf16_t*)(wsb + WS_WOUT2), 0, scr, it, lane);
                    else transpose_item(as_global(p->w_down) + (size_t)DFF * D, DFF, D, (bf16_t*)(wsb + WS_WD2), 0, scr, it - 32 * 32, lane); } }
        }
        if (ph + 1 < ph_hi) xcd_barrier(xbar, tid);
    }
}

extern "C" void kernel_launch(void* const* d_in, const int* in_sizes, int n_in, void* d_out, int out_size, void* d_ws, size_t ws_size, hipStream_t stream) {
    static int grid = 0;
    if (grid == 0) {
        int dev = 0, cus = 0, per_cu = 0;
        hipGetDevice(&dev); hipDeviceGetAttribute(&cus, hipDeviceAttributeMultiprocessorCount, dev);
        hipFuncSetAttribute((const void*)hymba_fwd, hipFuncAttributeMaxDynamicSharedMemorySize, LDS_BYTES);
        hipOccupancyMaxActiveBlocksPerMultiprocessor(&per_cu, (const void*)hymba_fwd, 512, LDS_BYTES);
        if (per_cu < 1) { fprintf(stderr, "occupancy query says %d blocks/CU\n", per_cu); per_cu = 1; }
        if (per_cu > 1) per_cu = 1;
        grid = cus * per_cu;
        if (ws_size < WS_END) fprintf(stderr, "workspace too small: %zu < %zu\n", ws_size, (size_t)WS_END);
    }
    if (hipMemsetAsync((char*)d_ws + WS_CTL, 0, CTL_BYTES, stream) != hipSuccess) { fprintf(stderr, "memset failed\n"); return; }
    Params p{};
    const float** pp = (const float**)&p;
    for (int i = 0; i < 20; ++i) pp[i] = (const float*)d_in[i];
    p.out = (float*)d_out; p.ws = (unsigned char*)d_ws;
#ifdef REP_PH
    { const int cuts[4][3] = {{0, REP_PH + 1, 0}, {REP_PH, REP_PH + 1, 1}, {REP_PH + 1, 19, 0}};
      for (int i = 0; i < 3; ++i) { p.ph_lo = cuts[i][0]; p.ph_hi = cuts[i][1]; p.dummy = cuts[i][2]; p.li = i; void* args[] = {&p};
        hipError_t e = hipLaunchCooperativeKernel((const void*)hymba_fwd, dim3(grid), dim3(512), args, LDS_BYTES, stream);
        if (e != hipSuccess) { fprintf(stderr, "launch failed: %s\n", hipGetErrorString(e)); break; } } }
#else
    p.ph_lo = 0; p.ph_hi = 19; void* args[] = {&p};
    hipError_t e = hipLaunchCooperativeKernel((const void*)hymba_fwd, dim3(grid), dim3(512), args, LDS_BYTES, stream);
    if (e != hipSuccess) fprintf(stderr, "cooperative launch failed: %s (grid %d)\n", hipGetErrorString(e), grid);
#endif
}
```

```cpp
#include <hip/hip_runtime.h>
#include <hip/hip_cooperative_groups.h>
#include <cstdio>
#include <cstdint>
#include <cmath>
namespace cg = cooperative_groups;

#define LAS __attribute__((address_space(3)))
typedef unsigned short bf16_t;
typedef short bf16x8 __attribute__((ext_vector_type(8)));
typedef float f32x4 __attribute__((ext_vector_type(4)));
typedef unsigned u32x2 __attribute__((ext_vector_type(2)));
typedef unsigned u32x4 __attribute__((ext_vector_type(4)));

constexpr int D = 2048, DIN = 5632, DFF = 5632, LP = 4112, NPROMPT = 2 * LP  , NSAMP = 128, NTOK = NPROMPT + NSAMP  , MP = 8448;
constexpr int PAST = 16384;
constexpr float EPS = 1e-6f;
constexpr int C_QA = 0, C_KA = 1024, C_VA = 1280, C_QB = 1536, C_FB = 2048, C_IB = 2560, C_GB = 3072, C_QC = 3584, C_KC = 4096, C_VC = 4608, C_GC = 5120;
constexpr size_t O_YP = 0, O_YS = 16777216, O_CKP = 17039360, O_CVP = 17170432, O_SHP = 17301504, O_SRP = 17563648, O_CKS = 17825792, O_CVS = 19922944, O_SHS = 22020096, O_SRS = 26214400;
constexpr size_t SZ_WIN = (size_t)DIN * D * 2, SZ_WOUT = (size_t)D * D * 2, SZ_WGU = (size_t)2 * DFF * D * 2, SZ_WD = (size_t)D * DFF * 2;
constexpr size_t WS_WIN = 0, WS_WOUT = WS_WIN + SZ_WIN, WS_WGU = WS_WOUT + SZ_WOUT, WS_WD = WS_WGU + SZ_WGU;
constexpr size_t WS_X = WS_WD + SZ_WD;
constexpr size_t WS_ACT = WS_X + (size_t)MP * D * 4;
constexpr size_t WS_P = WS_ACT + (size_t)MP * D * 2;
constexpr size_t WS_INTRA = WS_P + (size_t)MP * DIN * 2;
constexpr size_t WS_QI = WS_INTRA + (size_t)MP * 1024 * 4;
constexpr int NITEM = 648;
constexpr size_t WS_LS = WS_QI + (size_t)MP * 1024 * 2;
constexpr size_t WS_DEC = WS_LS + (size_t)2 * NITEM * 16384 * 4;
constexpr size_t WS_CTL = WS_DEC + (size_t)NITEM * 128 * 4;
constexpr size_t CTL_BYTES = 65536;
constexpr size_t WS_WIN2 = WS_CTL + CTL_BYTES, WS_WOUT2 = WS_WIN2 + SZ_WIN, WS_WD2 = WS_WOUT2 + SZ_WOUT;
constexpr size_t WS_END = WS_WD2 + SZ_WD;

constexpr int LDS_BYTES = 147456;

struct Params;
struct Params {
    const float *x_prompt, *x_sample, *cache_k, *cache_v, *state_hgrn, *state_ret, *meta, *norm_mix, *norm_ffn, *w_in, *q_norm, *k_norm, *sinks, *hgrn_lb,
        *hgrn_norm, *ret_norm, *w_out, *w_gate, *w_up, *w_down;
    float* out; unsigned char* ws;
    int ph_lo, ph_hi, dummy, li;
};

__constant__ float INV_A[8] = {1.000000000e+00f, 1.939227432e-01f, 3.760603070e-02f, 7.292664610e-03f, 1.414213562e-03f, 2.742481884e-04f, 5.318295734e-05f, 1.031338525e-05f};
__constant__ float INV_C[64] = {1.000000000e+00f, 8.659643531e-01f, 7.498942018e-01f, 6.493816376e-01f, 5.623413324e-01f, 4.869675338e-01f, 4.216965139e-01f, 3.651741147e-01f, 3.162277639e-01f, 2.738419771e-01f, 2.371373773e-01f, 2.053525001e-01f, 1.778279394e-01f, 1.539926529e-01f, 1.333521456e-01f, 1.154781953e-01f, 1.000000015e-01f, 8.659642935e-02f, 7.498942316e-02f, 6.493816525e-02f, 5.623413250e-02f, 4.869675264e-02f, 4.216964915e-02f, 3.651741147e-02f, 3.162277490e-02f, 2.738419548e-02f, 2.371373773e-02f, 2.053525113e-02f, 1.778279431e-02f, 1.539926510e-02f, 1.333521400e-02f, 1.154781971e-02f, 9.999999776e-03f, 8.659643121e-03f, 7.498942316e-03f, 6.493816152e-03f, 5.623413250e-03f, 4.869675264e-03f, 4.216964822e-03f, 3.651741194e-03f, 3.162277630e-03f, 2.738419687e-03f, 2.371373819e-03f, 2.053525066e-03f, 1.778279431e-03f, 1.539926510e-03f, 1.333521446e-03f, 1.154782018e-03f, 1.000000047e-03f, 8.659643354e-04f, 7.498941850e-04f, 6.493816036e-04f, 5.623413017e-04f, 4.869675322e-04f, 4.216965172e-04f, 3.651741135e-04f, 3.162277571e-04f, 2.738419571e-04f, 2.371373703e-04f, 2.053525095e-04f, 1.778279402e-04f, 1.539926598e-04f, 1.333521504e-04f, 1.154782003e-04f};
__constant__ float LG[4] = {-3.174869716e-02f, -1.574835740e-02f, -7.843177766e-03f, -3.913899418e-03f};

typedef const Params __attribute__((address_space(4)))* KP;

template <class T> __device__ __forceinline__ T* as_global(T* q) { return (T*)(__attribute__((address_space(1))) T*)(unsigned long long)q; }

__device__ __forceinline__ unsigned pk2(float lo, float hi);
__device__ __forceinline__ unsigned f2bf(float f) { return pk2(f, 0.f) & 0xffffu; }
typedef float f32x2_t __attribute__((ext_vector_type(2)));
typedef __bf16 bf16x2_t __attribute__((ext_vector_type(2)));
__device__ __forceinline__ unsigned pk2(float lo, float hi) { const f32x2_t v = {lo, hi}; const bf16x2_t b = __builtin_convertvector(v, bf16x2_t); return __builtin_bit_cast(unsigned, b); }
__device__ __forceinline__ unsigned f2bf_sw(float f) { unsigned u = __builtin_bit_cast(unsigned, f); return (u + 0x7fffu + ((u >> 16) & 1u)) >> 16; }
__device__ __forceinline__ unsigned pk2_sw(float lo, float hi) { return f2bf_sw(lo) | (f2bf_sw(hi) << 16); }
__device__ __forceinline__ float bf_lo(unsigned u) { return __builtin_bit_cast(float, u << 16); }
__device__ __forceinline__ float bf_hi(unsigned u) { return __builtin_bit_cast(float, u & 0xffff0000u); }
__device__ __forceinline__ float wave_sum(float v) {
#pragma unroll
    for (int o = 1; o < 64; o <<= 1) v += __shfl_xor(v, o);
    return v;
}
__device__ __forceinline__ float siluf(float x) { return x * __builtin_amdgcn_rcpf(1.f + __expf(-x)); }
__device__ __forceinline__ void sincos_red(float ang, float& s, float& c) {
    const float n = rintf(ang * 0.15915494309189535f);
    float r = fmaf(-n, 6.2831854820251465f, ang);
    r = fmaf(-n, -1.7484555e-7f, r);
    s = __sinf(r); c = __cosf(r);
}
#define LDS_WAIT() asm volatile("s_waitcnt lgkmcnt(0)" ::: "memory")
#define LDS_SYNC() do { asm volatile("s_waitcnt lgkmcnt(0)" ::: "memory"); __builtin_amdgcn_s_barrier(); asm volatile("" ::: "memory"); } while (0)

namespace pg8 {
constexpr int BM = 256, BK = 64, HALF = 128, HTB = HALF * BK * 2, NXCD = 8, WGM = 8;
__host__ __device__ __forceinline__ int lds_byte(int r, int c) { const int st = (r >> 4) * 2 + (c >> 5), rr = r & 15, cc = c & 31, ob = rr * 64 + cc * 2; return st * 1024 + (ob ^ (((ob >> 9) & 1) << 5)); }
__host__ __device__ __forceinline__ void stage_rc(int b, int& R, int& C) { const int st = b / 1024, sb = b % 1024, swz = sb ^ (((sb >> 9) & 1) << 5); R = (st >> 1) * 16 + swz / 64; C = (st & 1) * 32 + (swz % 64) / 2; }
struct Unit { int pm, pn, k0, nt; };
struct Gemm { const bf16_t* A; const bf16_t* Bt; int M, N, K; };
struct StaticOrder {
    int nM, nN, nwg, G, c, ntk, nExtra;
    __device__ __forceinline__ void init(int M, int N, int K, int G_, int c_, bool tail) { nM = M / BM; nN = N / BM; ntk = K / BK; G = G_; c = c_; nExtra = 0; if (tail) { nM -= 1; nExtra = nN * (ntk / 8); } nwg = nM * nN; }
    __device__ __forceinline__ bool next(int i, Unit& u) const {
        const long L = (long)i * G + c; const bool full = L < nwg; const int ei = full ? 0 : (int)(L - nwg);
        if (!full && ei >= nExtra) return false;
        int wgid = full ? (int)L : 0; { const int q = nwg / NXCD, r = nwg % NXCD, xcd = wgid % NXCD, off = wgid / NXCD; wgid = (xcd < r ? xcd * (q + 1) : r * (q + 1) + (xcd - r) * q) + off; }
        const int nig = WGM * nN, gid = wgid / nig, fm = gid * WGM, gsz = (nM - fm) < WGM ? (nM - fm) : WGM;
        const int pmf = fm + ((wgid % nig) % gsz), pnf = (wgid % nig) / gsz;
        u.pm = full ? pmf : nM; u.pn = full ? pnf : (ei % nN); u.k0 = full ? 0 : 8 * (ei / nN); u.nt = full ? ntk : 8; return true;
    }
};
struct EpiBf16 {
    bf16_t* O; int ldc;
    __device__ __forceinline__ void operator()(const f32x4 (&acc)[2][2][4][2], const Unit& u, int wr, int wc, int fr, int fq) const {
        const int row0 = u.pm * BM + wr * 64 + fr, col0 = u.pn * BM + wc * 32 + 8 * fq;
#pragma unroll
        for (int ai = 0; ai < 2; ++ai)
#pragma unroll
            for (int m = 0; m < 4; ++m) { bf16_t* rowp = O + (size_t)(row0 + ai * HALF + m * 16) * ldc + col0;
#pragma unroll
                for (int bj = 0; bj < 2; ++bj) { const f32x4 v0 = acc[ai][bj][m][0], v1 = acc[ai][bj][m][1]; u32x4 w; w.x = pk2(v0[0], v0[1]); w.y = pk2(v0[2], v0[3]); w.z = pk2(v1[0], v1[1]); w.w = pk2(v1[2], v1[3]);
                    *(u32x4*)(rowp + bj * HALF) = w; } }
    }
};
struct EpiResid {
    float* X; float* out; int ntk; float* part; const float* in_meta; const float* in_prompt;
    __device__ __forceinline__ void operator()(const f32x4 (&acc)[2][2][4][2], const Unit& u, int wr, int wc, int fr, int fq) const {
        const int row0 = u.pm * BM + wr * 64 + fr, col0 = u.pn * BM + wc * 32 + 4 * fq;
        if (u.nt != ntk) {
            float* pb = part + (size_t)(u.k0 >> 3) * (160 * D);
#pragma unroll
            for (int ai = 0; ai < 2; ++ai)
#pragma unroll
                for (int m = 0; m < 4; ++m) { const int r = wr * 64 + fr + ai * HALF + m * 16; float* xr = pb + (size_t)r * D + col0;
                    if (r < 160) {
#pragma unroll
                        for (int bj = 0; bj < 2; ++bj)
#pragma unroll
                            for (int n = 0; n < 2; ++n) *(f32x4*)(xr + bj * HALF + n * 16) = acc[ai][bj][m][n]; } }
            return;
        }
#pragma unroll
        for (int ai = 0; ai < 2; ++ai)
#pragma unroll
            for (int m = 0; m < 4; ++m) { const int row = row0 + ai * HALF + m * 16; float* xr = X + (size_t)row * D + col0; float* orow = nullptr; const float* src = xr;
                const int b = row / LP, t = row - b * LP;
                if (out) { if (t >= 16) orow = out + O_YP + ((size_t)(b * 4096 + t - 16)) * D + col0; }
                if (in_prompt) src = (t < 16) ? in_meta + (size_t)t * D + col0 : in_prompt + ((size_t)(b * 4096 + t - 16)) * D + col0;
#pragma unroll
                for (int bj = 0; bj < 2; ++bj)
#pragma unroll
                    for (int n = 0; n < 2; ++n) { f32x4 v = *(const f32x4*)(src + bj * HALF + n * 16) + acc[ai][bj][m][n]; *(f32x4*)(xr + bj * HALF + n * 16) = v; if (orow) *(f32x4*)(orow + bj * HALF + n * 16) = v; } }
    }
};
struct EpiSwiglu {
    bf16_t* U;
    __device__ __forceinline__ void operator()(const f32x4 (&acc)[2][2][4][2], const Unit& u, int wr, int wc, int fr, int fq) const {
        const int row0 = u.pm * BM + wr * 64 + fr, col0 = u.pn * 128 + wc * 32 + 8 * fq;
#pragma unroll
        for (int ai = 0; ai < 2; ++ai)
#pragma unroll
            for (int m = 0; m < 4; ++m) { bf16_t* rowp = U + (size_t)(row0 + ai * HALF + m * 16) * DFF + col0;
                const f32x4 g0 = acc[ai][0][m][0], u0 = acc[ai][0][m][1], g1 = acc[ai][1][m][0], u1 = acc[ai][1][m][1]; u32x4 w;
                w.x = pk2(siluf(g0[0]) * u0[0], siluf(g0[1]) * u0[1]); w.y = pk2(siluf(g0[2]) * u0[2], siluf(g0[3]) * u0[3]);
                w.z = pk2(siluf(g1[0]) * u1[0], siluf(g1[1]) * u1[1]); w.w = pk2(siluf(g1[2]) * u1[2], siluf(g1[3]) * u1[3]);
                *(u32x4*)rowp = w; }
    }
};

template <class Epi>
__device__ __forceinline__ void gemm_phase(LAS unsigned char* lds, const Gemm g, const StaticOrder& S, const Epi& E, const int tid) {
    const int wid = __builtin_amdgcn_readfirstlane(tid >> 6), lane = tid & 63, wr = wid >> 2, wc = wid & 3, fr = lane & 15, fq = lane >> 4;
    const int K = g.K;
    unsigned voffA[2];
#pragma unroll
    for (int i = 0; i < 2; ++i) { int R, C; stage_rc(tid * 16 + i * 8192, R, C); voffA[i] = (unsigned)(R * K + C) * 2u; }
    const size_t kstep = (size_t)(BK * 2);
    const size_t hstep = (size_t)HALF * K * 2;
    const size_t tstep = 2 * hstep;
    const unsigned ldsw = (unsigned)wid * 1024u;
    const int aoff = lds_byte(wr * 64 + fr, fq * 8), boff = lds_byte(wc * 32 + fr, fq * 8);
#define PG8_SA(b, h) (((b) * 2 + (h)) * HTB)
#define PG8_SB(b, h) ((4 + (b) * 2 + (h)) * HTB)
#define PG8_STAGE(bufoff, gbase, voff) do { _Pragma("unroll") for (int _i = 0; _i < 2; ++_i) \
        __builtin_amdgcn_global_load_lds((const unsigned*)((const char*)(gbase) + (voff)[_i]), (LAS unsigned*)(lds + (bufoff) + ldsw + _i * 8192), 16, 0, 0); } while (0)
#define PG8_LDA(dst, b, h) do { _Pragma("unroll") for (int m = 0; m < 4; ++m) _Pragma("unroll") for (int k = 0; k < 2; ++k) dst[m][k] = *(const LAS bf16x8*)(lds + PG8_SA(b, h) + aoff + m * 2048 + k * 1024); } while (0)
#define PG8_LDB(dst, b, h) do { _Pragma("unroll") for (int n = 0; n < 2; ++n) _Pragma("unroll") for (int k = 0; k < 2; ++k) dst[n][k] = *(const LAS bf16x8*)(lds + PG8_SB(b, h) + boff + n * 2048 + k * 1024); } while (0)
#define PG8_MMA(ai, bj, At, Bt) do { __builtin_amdgcn_s_setprio(1); _Pragma("unroll") for (int m = 0; m < 4; ++m) _Pragma("unroll") for (int n = 0; n < 2; ++n) _Pragma("unroll") for (int k = 0; k < 2; ++k) \
        acc[ai][bj][m][n] = __builtin_amdgcn_mfma_f32_16x16x32_bf16(Bt[n][k], At[m][k], acc[ai][bj][m][n], 0, 0, 0); __builtin_amdgcn_s_setprio(0); } while (0)
#define PG8_WAIT_V(n) asm volatile("s_waitcnt vmcnt(" #n ")" ::: "memory")
#define PG8_WAIT_L(n) asm volatile("s_waitcnt lgkmcnt(" #n ")" ::: "memory")
#define PG8_BAR __builtin_amdgcn_s_barrier()
#define PG8_SCHED __builtin_amdgcn_sched_barrier(0)
    Unit cur, nxt; int ui = 0;
    if (!S.next(0, cur)) return;
    f32x4 acc[2][2][4][2];
#pragma unroll
    for (int a = 0; a < 2; ++a)
#pragma unroll
        for (int b = 0; b < 2; ++b)
#pragma unroll
            for (int m = 0; m < 4; ++m)
#pragma unroll
                for (int n = 0; n < 2; ++n) acc[a][b][m][n] = (f32x4){0.f, 0.f, 0.f, 0.f};
    bf16x8 At[4][2], B0[2][2], B1[2][2];
    const char* cA = (const char*)g.A + (size_t)cur.pm * tstep + (size_t)cur.k0 * kstep; const char* cB = (const char*)g.Bt + (size_t)cur.pn * tstep + (size_t)cur.k0 * kstep;
    PG8_STAGE(PG8_SB(0, 0), cB, voffA); PG8_STAGE(PG8_SB(0, 1), cB + hstep, voffA); PG8_STAGE(PG8_SA(0, 0), cA, voffA); PG8_STAGE(PG8_SA(0, 1), cA + hstep, voffA);
    if (wr == 1) PG8_BAR;
    PG8_WAIT_V(2); PG8_BAR;
    PG8_STAGE(PG8_SB(1, 0), cB + kstep, voffA); PG8_STAGE(PG8_SA(1, 0), cA + kstep, voffA); PG8_STAGE(PG8_SB(1, 1), cB + hstep + kstep, voffA);
    PG8_WAIT_V(6); PG8_BAR;
    for (;;) {
        const bool has_next = S.next(ui + 1, nxt);
        const char* nA = has_next ? (const char*)g.A + (size_t)nxt.pm * tstep + (size_t)nxt.k0 * kstep : cA; const char* nB = has_next ? (const char*)g.Bt + (size_t)nxt.pn * tstep + (size_t)nxt.k0 * kstep : cB;
        const int nt = cur.nt;
        for (int t = 0; t < nt; t += 2) {
            const bool last = (t == nt - 2);
            const char* a1 = cA + (size_t)(t + 1) * kstep;
            const char* a2 = last ? nA : cA + (size_t)(t + 2) * kstep; const char* b2 = last ? nB : cB + (size_t)(t + 2) * kstep;
            const char* a3 = a2 + kstep; const char* b3 = b2 + kstep;
            PG8_LDB(B0, 0, 0); PG8_LDB(B1, 0, 1); PG8_SCHED; PG8_LDA(At, 0, 0); PG8_STAGE(PG8_SA(1, 1), a1 + hstep, voffA);
            PG8_WAIT_V(8); PG8_WAIT_L(0); PG8_BAR; PG8_MMA(0, 0, At, B0); PG8_MMA(0, 1, At, B1); PG8_BAR; PG8_SCHED;
            PG8_LDA(At, 0, 1); PG8_STAGE(PG8_SB(0, 0), b2, voffA); PG8_STAGE(PG8_SB(0, 1), b2 + hstep, voffA); PG8_STAGE(PG8_SA(0, 0), a2, voffA);
            PG8_WAIT_V(8); PG8_WAIT_L(0); PG8_BAR; PG8_MMA(1, 0, At, B0); PG8_MMA(1, 1, At, B1); PG8_BAR; PG8_SCHED;
            PG8_LDB(B0, 1, 0); PG8_LDB(B1, 1, 1); PG8_SCHED; PG8_LDA(At, 1, 0); PG8_STAGE(PG8_SA(0, 1), a2 + hstep, voffA);
            PG8_WAIT_V(8); PG8_WAIT_L(0); PG8_BAR; PG8_MMA(0, 0, At, B0); PG8_MMA(0, 1, At, B1); PG8_BAR; PG8_SCHED;
            PG8_LDA(At, 1, 1); PG8_STAGE(PG8_SB(1, 0), b3, voffA); PG8_STAGE(PG8_SB(1, 1), b3 + hstep, voffA); PG8_STAGE(PG8_SA(1, 0), a3, voffA);
            PG8_WAIT_V(8); PG8_WAIT_L(0); PG8_BAR; PG8_MMA(1, 0, At, B0); PG8_MMA(1, 1, At, B1); PG8_BAR; PG8_SCHED;
        }
        if (wr == 0) PG8_BAR;
        E(acc, cur, wr, wc, fr, fq);
        if (!has_next) break;
#pragma unroll
        for (int a = 0; a < 2; ++a)
#pragma unroll
            for (int b = 0; b < 2; ++b)
#pragma unroll
                for (int m = 0; m < 4; ++m)
#pragma unroll
                    for (int n = 0; n < 2; ++n) acc[a][b][m][n] = (f32x4){0.f, 0.f, 0.f, 0.f};
        cur = nxt; cA = nA; cB = nB; ++ui;
        if (wr == 1) PG8_BAR;
    }
    PG8_WAIT_V(0);
    PG8_BAR;
#undef PG8_SA
#undef PG8_SB
#undef PG8_STAGE
#undef PG8_LDA
#undef PG8_LDB
#undef PG8_MMA
#undef PG8_WAIT_V
#undef PG8_WAIT_L
#undef PG8_BAR
#undef PG8_SCHED
}
}

__device__ __forceinline__ void transpose_item(const float* W, int K, int N, bf16_t* WT, int mode, LAS float* scr, int item, int lane) {
    const int nblk = N / 64, kb = item / nblk, nb = item - kb * nblk, k0 = 64 * kb, n0 = 64 * nb;
    const int lr = lane >> 4, lc = (lane & 15) * 4;
    f32x4 v[16];
#pragma unroll
    for (int i = 0; i < 16; ++i) v[i] = *(const f32x4*)(W + (size_t)(k0 + 4 * i + lr) * N + n0 + lc);
#pragma unroll
    for (int i = 0; i < 16; ++i) { LAS float* d = scr + (4 * i + lr) * 65 + lc; d[0] = v[i][0]; d[1] = v[i][1]; d[2] = v[i][2]; d[3] = v[i][3]; }
    LDS_WAIT();
    const int c = lane & 7;
#pragma unroll
    for (int j = 0; j < 8; ++j) { const int n = (lane >> 3) + 8 * j; const LAS float* s = scr + (8 * c) * 65 + n;
        u32x4 o; o.x = pk2(s[0 * 65], s[1 * 65]); o.y = pk2(s[2 * 65], s[3 * 65]); o.z = pk2(s[4 * 65], s[5 * 65]); o.w = pk2(s[6 * 65], s[7 * 65]);
        const int nn = n0 + n;
        const int orow = (mode == 0) ? nn
                       : (mode == 3) ? ((nn & ~31) + 16 * ((nn & 7) >> 2) + 4 * ((nn & 31) >> 3) + (nn & 3))
                       : (256 * (nn >> 7) + 128 * ((nn & 7) >> 2) + 32 * ((nn & 127) >> 5) + 16 * (mode - 1) + 4 * ((nn & 31) >> 3) + (nn & 3));
        *(u32x4*)(WT + (size_t)orow * K + k0 + 8 * c) = o; }
    LDS_WAIT();
}
__device__ __forceinline__ void norm_row(const float* xrow, const float* g, bf16_t* orow, float* xcopy, int lane, const float* part, int nparts) {
    f32x4 v[8]; float s = 0.f;
#pragma unroll
    for (int j = 0; j < 8; ++j) v[j] = xrow ? ((const f32x4*)xrow)[lane + 64 * j] : (f32x4){0.f, 0.f, 0.f, 0.f};
    for (int kp = 0; kp + 3 < nparts; kp += 4) {
        f32x4 t[4][8];
#pragma unroll
        for (int q = 0; q < 4; ++q)
#pragma unroll
            for (int j = 0; j < 8; ++j) t[q][j] = ((const f32x4*)(part + (size_t)(kp + q) * (160 * D)))[lane + 64 * j];
#pragma unroll
        for (int q = 0; q < 4; ++q)
#pragma unroll
            for (int j = 0; j < 8; ++j) v[j] = v[j] + t[q][j]; }
    for (int kp = nparts & ~3; kp < nparts; ++kp) {
#pragma unroll
        for (int j = 0; j < 8; ++j) v[j] = v[j] + ((const f32x4*)(part + (size_t)kp * (160 * D)))[lane + 64 * j]; }
#pragma unroll
    for (int j = 0; j < 8; ++j) s += (v[j][0] * v[j][0] + v[j][1] * v[j][1]) + (v[j][2] * v[j][2] + v[j][3] * v[j][3]);
    const float r = rsqrtf(wave_sum(s) * (1.f / D) + EPS);
#pragma unroll
    for (int j = 0; j < 8; ++j) { const f32x4 gg = ((const f32x4*)g)[lane + 64 * j]; u32x2 w; w.x = pk2(v[j][0] * r * gg[0], v[j][1] * r * gg[1]); w.y = pk2(v[j][2] * r * gg[2], v[j][3] * r * gg[3]);
        ((u32x2*)orow)[lane + 64 * j] = w; if (xcopy) ((f32x4*)xcopy)[lane + 64 * j] = v[j]; }
}

__device__ __forceinline__ void norm_row2(const float* x0, const float* x1, const float* g, bf16_t* o0, bf16_t* o1, float* c0, float* c1, int lane) {
    f32x4 a[8], b[8]; float s0 = 0.f, s1 = 0.f;
#pragma unroll
    for (int j = 0; j < 8; ++j) a[j] = x0 ? ((const f32x4*)x0)[lane + 64 * j] : (f32x4){0.f, 0.f, 0.f, 0.f};
#pragma unroll
    for (int j = 0; j < 8; ++j) b[j] = x1 ? ((const f32x4*)x1)[lane + 64 * j] : (f32x4){0.f, 0.f, 0.f, 0.f};
#pragma unroll
    for (int j = 0; j < 8; ++j) { s0 += (a[j][0] * a[j][0] + a[j][1] * a[j][1]) + (a[j][2] * a[j][2] + a[j][3] * a[j][3]); s1 += (b[j][0] * b[j][0] + b[j][1] * b[j][1]) + (b[j][2] * b[j][2] + b[j][3] * b[j][3]); }
    const float r0 = rsqrtf(wave_sum(s0) * (1.f / D) + EPS), r1 = rsqrtf(wave_sum(s1) * (1.f / D) + EPS);
#pragma unroll
    for (int j = 0; j < 8; ++j) { const f32x4 gg = ((const f32x4*)g)[lane + 64 * j]; u32x2 w;
        w.x = pk2(a[j][0] * r0 * gg[0], a[j][1] * r0 * gg[1]); w.y = pk2(a[j][2] * r0 * gg[2], a[j][3] * r0 * gg[3]); ((u32x2*)o0)[lane + 64 * j] = w; if (c0) ((f32x4*)c0)[lane + 64 * j] = a[j];
        w.x = pk2(b[j][0] * r1 * gg[0], b[j][1] * r1 * gg[1]); w.y = pk2(b[j][2] * r1 * gg[2], b[j][3] * r1 * gg[3]); ((u32x2*)o1)[lane + 64 * j] = w; if (c1) ((f32x4*)c1)[lane + 64 * j] = b[j]; }
}

__device__ __forceinline__ bf16x8 frag(const LAS bf16_t* base, int row0, int ld, int k0, int fr, int fq) { return *(const LAS bf16x8*)(base + (row0 + fr) * ld + k0 + fq * 8); }
typedef short v4i16_t __attribute__((ext_vector_type(4)));
__device__ __forceinline__ bf16x8 frag_tr(const LAS bf16_t* base, int ld, int k0, int n0, int lane) {
    const LAS bf16_t* a = base + (k0 + (lane >> 4) * 8 + ((lane >> 2) & 3)) * ld + n0 + 4 * (lane & 3);
    const v4i16_t lo = __builtin_amdgcn_ds_read_tr16_b64_v4i16((LAS v4i16_t*)a), hi = __builtin_amdgcn_ds_read_tr16_b64_v4i16((LAS v4i16_t*)(a + 4 * ld));
    return (bf16x8){lo[0], lo[1], lo[2], lo[3], hi[0], hi[1], hi[2], hi[3]};
}
#define MFMA16(a, b, c) __builtin_amdgcn_mfma_f32_16x16x32_bf16((a), (b), (c), 0, 0, 0)

struct AttnRaw { u32x2 k[6], v[6], q[8]; };
__device__ __forceinline__ AttnRaw attn_load(KP p, int it, int tid) { AttnRaw r;
    const bf16_t* P = (const bf16_t*)(as_global(p->ws) + WS_P);
    const int b = it / 260, rem = it - b * 260, hkv = rem / 65, ch = rem - hkv * 65; const int q0pos = ch ? 16 + 64 * (ch - 1) : 0, nq = ch ? 64 : 16, rowq0 = b * LP + q0pos;
    const int sub = tid & 15, r16 = tid >> 4;
#pragma unroll
    for (int ps = 0; ps < 6; ++ps) { const int pos = q0pos - 128 + ps * 32 + r16; const bf16_t* pr = P + (size_t)(b * LP + (pos < 0 ? 0 : pos)) * DIN + hkv * 64 + sub * 4;
        r.k[ps] = *(const u32x2*)(pr + C_KA); r.v[ps] = *(const u32x2*)(pr + C_VA); }
#pragma unroll
    for (int ps = 0; ps < 8; ++ps) { const int rowl = ps * 32 + r16, g = rowl >> 6, t = rowl & 63; r.q[ps] = (u32x2){0u, 0u};
        if (t < nq) r.q[ps] = *(const u32x2*)(P + (size_t)(rowq0 + t) * DIN + C_QA + (hkv * 4 + g) * 64 + sub * 4); }
    return r;
}
__device__ __forceinline__ void attn_item(KP p, int l, int it, int it_next, AttnRaw& raw, LAS unsigned char* lds, int tid) {
    const int lane = tid & 63, w = tid >> 6, fr = lane & 15, fq = lane >> 4;
    LAS bf16_t* Qs = (LAS bf16_t*)lds;
    LAS bf16_t* Ks = (LAS bf16_t*)(lds + 36864);
    LAS bf16_t* Vt = (LAS bf16_t*)(lds + 64512);
    LAS float* CS = (LAS float*)(lds + 92160);
    const bf16_t* P = (const bf16_t*)(as_global(p->ws) + WS_P);
    bf16_t* MIX = (bf16_t*)(as_global(p->ws) + WS_ACT);
    const bool samp = it >= 520;
    int b, hkv, q0pos, nq, rowq0;
    if (!samp) { b = it / 260; const int rem = it - b * 260; hkv = rem / 65; const int ch = rem - hkv * 65; q0pos = ch ? 16 + 64 * (ch - 1) : 0; nq = ch ? 64 : 16; rowq0 = b * LP + q0pos; }
    else { const int s = it - 520; b = s >> 2; hkv = s & 3; q0pos = PAST; nq = 4; rowq0 = NPROMPT + b * 4; }
    const int sub = tid & 15, r16 = tid >> 4;
    const f32x4 kn = *(const f32x4*)(as_global(p->k_norm) + l * 64 + sub * 4), qn = *(const f32x4*)(as_global(p->q_norm) + l * 64 + sub * 4);
    f32x4 kv[6], vv[6]; u32x2 qraw[8];
    if (!samp) {
#pragma unroll
        for (int ps = 0; ps < 6; ++ps) { const int pos = q0pos - 128 + ps * 32 + r16; const u32x2 a = raw.k[ps], c = raw.v[ps];
            kv[ps] = (f32x4){bf_lo(a.x), bf_hi(a.x), bf_lo(a.y), bf_hi(a.y)}; vv[ps] = (f32x4){bf_lo(c.x), bf_hi(c.x), bf_lo(c.y), bf_hi(c.y)};
            if (pos < 0) { kv[ps] = (f32x4){0.f, 0.f, 0.f, 0.f}; vv[ps] = (f32x4){0.f, 0.f, 0.f, 0.f}; } }
#pragma unroll
        for (int ps = 0; ps < 8; ++ps) qraw[ps] = raw.q[ps];
    } else {
#pragma unroll
        for (int ps = 0; ps < 4; ++ps) { const int j = ps * 32 + r16; const size_t o = ((size_t)((l * 32 + b) * 128 + j)) * 256 + hkv * 64 + sub * 4; kv[ps] = *(const f32x4*)(as_global(p->cache_k) + o); vv[ps] = *(const f32x4*)(as_global(p->cache_v) + o); }
        { kv[4] = (f32x4){0.f, 0.f, 0.f, 0.f}; vv[4] = kv[4]; kv[5] = kv[4]; vv[5] = kv[4];
          if (r16 < 4) { const bf16_t* pr = P + (size_t)(NPROMPT + b * 4 + r16) * DIN + hkv * 64 + sub * 4; const u32x2 a = *(const u32x2*)(pr + C_KA), c = *(const u32x2*)(pr + C_VA);
              kv[4] = (f32x4){bf_lo(a.x), bf_hi(a.x), bf_lo(a.y), bf_hi(a.y)}; vv[4] = (f32x4){bf_lo(c.x), bf_hi(c.x), bf_lo(c.y), bf_hi(c.y)}; } }
    }
    if (samp) {
#pragma unroll
        for (int ps = 0; ps < 8; ++ps) { const int rowl = ps * 32 + r16, g = rowl >> 6, t = rowl & 63; qraw[ps] = (u32x2){0u, 0u};
            if (t < nq) qraw[ps] = *(const u32x2*)(P + (size_t)(rowq0 + t) * DIN + C_QA + (hkv * 4 + g) * 64 + sub * 4); } }
    if (it_next < 520) { int tid2 = tid; asm volatile("" : "+v"(tid2)); raw = attn_load(p, it_next, tid2); }
#pragma unroll
    for (int r = 0; r < 3; ++r) { const int e = tid + r * 512; const int pos = q0pos - 128 + (e >> 3); float s, c; sincos_red((float)pos * INV_A[e & 7], s, c); CS[2 * e] = c; CS[2 * e + 1] = s; }
    LDS_SYNC();
#pragma unroll
    for (int ps = 0; ps < 6; ++ps) {
        const int j = ps * 32 + r16; const int pos = q0pos - 128 + j;
        const bool proc = samp ? (j >= 128 && j < 132) : (pos >= 0);
        f32x4 k4 = kv[ps]; const f32x4 v4 = vv[ps];
        float ss = (k4[0] * k4[0] + k4[1] * k4[1]) + (k4[2] * k4[2] + k4[3] * k4[3]);
        ss += __shfl_xor(ss, 1); ss += __shfl_xor(ss, 2); ss += __shfl_xor(ss, 4); ss += __shfl_xor(ss, 8);
        if (proc) { const float r = rsqrtf(ss * (1.f / 64.f) + EPS); k4 = k4 * r * kn; }
        f32x4 pt; pt[0] = __shfl_xor(k4[0], 2); pt[1] = __shfl_xor(k4[1], 2); pt[2] = __shfl_xor(k4[2], 2); pt[3] = __shfl_xor(k4[3], 2);
        { const LAS f32x4* cs = (const LAS f32x4*)(CS + (j * 8 + (sub & 1) * 4) * 2); const f32x4 c01 = cs[0], c23 = cs[1];
          const float cc[4] = {c01[0], c01[2], c23[0], c23[2]}, sn[4] = {c01[1], c01[3], c23[1], c23[3]};
          if (proc && sub < 4) {
#pragma unroll
              for (int e = 0; e < 4; ++e) k4[e] = (sub < 2) ? (k4[e] * cc[e] - pt[e] * sn[e]) : (k4[e] * cc[e] + pt[e] * sn[e]); } }
        u32x2 kw; kw.x = pk2(k4[0], k4[1]); kw.y = pk2(k4[2], k4[3]); *(LAS u32x2*)(Ks + j * 72 + sub * 4) = kw;
        { u32x2 vw; vw.x = pk2(v4[0], v4[1]); vw.y = pk2(v4[2], v4[3]); *(LAS u32x2*)(Vt + j * 72 + sub * 4) = vw; }
        if (!samp) { if (j >= 128 && pos >= LP - 128) { const size_t o = ((size_t)((l * 2 + b) * 128 + pos - (LP - 128))) * 256 + hkv * 64 + sub * 4; *(f32x4*)(as_global(p->out) + O_CKP + o) = k4; *(f32x4*)(as_global(p->out) + O_CVP + o) = v4; } }
        else if (j >= 4 && j < 132) { const size_t o = ((size_t)((l * 32 + b) * 128 + j - 4)) * 256 + hkv * 64 + sub * 4; *(f32x4*)(as_global(p->out) + O_CKS + o) = k4; *(f32x4*)(as_global(p->out) + O_CVS + o) = v4; }
    }
#pragma unroll
    for (int ps = 0; ps < 8; ++ps) {
        const int rowl = ps * 32 + r16, t = rowl & 63;
        f32x4 q4 = (f32x4){bf_lo(qraw[ps].x), bf_hi(qraw[ps].x), bf_lo(qraw[ps].y), bf_hi(qraw[ps].y)};
        float ss = (q4[0] * q4[0] + q4[1] * q4[1]) + (q4[2] * q4[2] + q4[3] * q4[3]);
        ss += __shfl_xor(ss, 1); ss += __shfl_xor(ss, 2); ss += __shfl_xor(ss, 4); ss += __shfl_xor(ss, 8);
        { const float r = rsqrtf(ss * (1.f / 64.f) + EPS); q4 = q4 * r * qn; }
        f32x4 pt; pt[0] = __shfl_xor(q4[0], 2); pt[1] = __shfl_xor(q4[1], 2); pt[2] = __shfl_xor(q4[2], 2); pt[3] = __shfl_xor(q4[3], 2);
        { const LAS f32x4* cs = (const LAS f32x4*)(CS + ((128 + t) * 8 + (sub & 1) * 4) * 2); const f32x4 c01 = cs[0], c23 = cs[1];
          const float cc[4] = {c01[0], c01[2], c23[0], c23[2]}, sn[4] = {c01[1], c01[3], c23[1], c23[3]};
          if (sub < 4) {
#pragma unroll
              for (int e = 0; e < 4; ++e) q4[e] = (sub < 2) ? (q4[e] * cc[e] - pt[e] * sn[e]) : (q4[e] * cc[e] + pt[e] * sn[e]); } }
        q4 = q4 * 0.125f;
        u32x2 qw; qw.x = pk2(q4[0], q4[1]); qw.y = pk2(q4[2], q4[3]); *(LAS u32x2*)(Qs + rowl * 72 + sub * 4) = qw;
    }
    LDS_SYNC();
    const int tb = (w & 1) * 32, g = w >> 1, hq = hkv * 4 + g;
    const float sk = as_global(p->sinks)[l * 16 + hq];
    const int jlo = samp ? 0 : (128 - q0pos);
#pragma unroll 1
    for (int mt = 0; mt < 2; ++mt) {
        if (tb + mt * 16 >= nq) continue;
        const int rb = w * 32 + mt * 16;
        const bf16x8 qb0 = frag(Qs, rb, 72, 0, fr, fq), qb1 = frag(Qs, rb, 72, 32, fr, fq);
        f32x4 sacc[12];
        const int T0 = tb + mt * 16, n0 = T0 >> 4;
        const bool early = jlo > 0;
#pragma unroll
        for (int nt = 0; nt < 12; ++nt) { f32x4 z = {0.f, 0.f, 0.f, 0.f};
            if (nt >= n0 && nt <= n0 + 8) { z = MFMA16(frag(Ks, nt * 16, 72, 0, fr, fq), qb0, z); z = MFMA16(frag(Ks, nt * 16, 72, 32, fr, fq), qb1, z); }
            sacc[nt] = z; }
        const int t = T0 + fr; const int lo = (t + 1 > jlo) ? t + 1 : jlo; const unsigned span = (unsigned)(t + 128 - lo);
        float mx = -1e30f;
#pragma unroll
        for (int nt = 0; nt < 12; ++nt) { if (nt >= n0 && nt <= n0 + 8) {
#pragma unroll
                for (int i = 0; i < 4; ++i) { float sv = sacc[nt][i];
                    if (early || nt == n0 || nt == n0 + 8) { const int j = nt * 16 + 4 * fq + i; sv = ((unsigned)(j - lo) <= span) ? sv : -1e30f; sacc[nt][i] = sv; }
                    mx = fmaxf(mx, sv); } } }
        mx = fmaxf(mx, __shfl_xor(mx, 16)); mx = fmaxf(mx, __shfl_xor(mx, 32));
        mx = fmaxf(mx, sk); float sum = 0.f;
#pragma unroll
        for (int nt = 0; nt < 12; ++nt) { if (nt >= n0 && nt <= n0 + 8) {
#pragma unroll
                for (int i = 0; i < 4; ++i) { const float e = __expf(sacc[nt][i] - mx); sacc[nt][i] = e; sum += e; } } }
        sum += __shfl_xor(sum, 16); sum += __shfl_xor(sum, 32);
        const float inv = __builtin_amdgcn_rcpf(sum + __expf(sk - mx));
        f32x4 oacc[4];
#pragma unroll
        for (int dt = 0; dt < 4; ++dt) oacc[dt] = (f32x4){0.f, 0.f, 0.f, 0.f};
#pragma unroll
        for (int m = 0; m < 6; ++m) {
            if (2 * m + 1 >= n0 && 2 * m <= n0 + 8) {
                const f32x4 pa = sacc[2 * m] * inv, pc = sacc[2 * m + 1] * inv;
                const u32x4 pw = {pk2(pa[0], pa[1]), pk2(pa[2], pa[3]), pk2(pc[0], pc[1]), pk2(pc[2], pc[3])};
                const bf16x8 pb = __builtin_bit_cast(bf16x8, pw);
                const LAS bf16_t* va = Vt + (32 * m + fq * 4 + ((lane >> 2) & 3)) * 72 + 8 * (lane & 3);
#pragma unroll
                for (int dt = 0; dt < 4; ++dt) { const int co = 32 * (dt >> 1) + 4 * (dt & 1); const v4i16_t vl = __builtin_amdgcn_ds_read_tr16_b64_v4i16((LAS v4i16_t*)(va + co)), vh = __builtin_amdgcn_ds_read_tr16_b64_v4i16((LAS v4i16_t*)(va + 16 * 72 + co));
                    oacc[dt] = MFMA16(((bf16x8){vl[0], vl[1], vl[2], vl[3], vh[0], vh[1], vh[2], vh[3]}), pb, oacc[dt]); } } }
        if (t < nq) {
#pragma unroll
            for (int e = 0; e < 2; ++e) { const f32x4 o0 = oacc[2 * e], o1 = oacc[2 * e + 1]; u32x4 ow; ow.x = pk2(o0[0], o0[1]); ow.y = pk2(o0[2], o0[3]); ow.z = pk2(o1[0], o1[1]); ow.w = pk2(o1[2], o1[3]);
                *(u32x4*)(MIX + (size_t)(rowq0 + t) * D + hq * 64 + 32 * e + 8 * fq) = ow; } }
    }
    LDS_SYNC();
}

struct ChunkRaw { u32x2 a[4], b[4], c[4]; };
__device__ __forceinline__ void chunk_load(KP p, int mx, int it, int tid, ChunkRaw& r) {
    const bf16_t* P = (const bf16_t*)(as_global(p->ws) + WS_P);
    const bool samp = it >= 520; int h, nq, rowbase;
    if (!samp) { const int seq = it / 65, c = it - seq * 65; const int b = seq >> 2; h = seq & 3; const int q0 = c ? 16 + 64 * (c - 1) : 0; nq = c ? 64 : 16; rowbase = b * LP + q0; }
    else { const int s = it - 520; const int b = s >> 2; h = s & 3; nq = 4; rowbase = NPROMPT + b * 4; }
    const int c4 = (tid & 31) * 4, tr = tid >> 5, i2 = (tid & 31) * 2;
#pragma unroll
    for (int ps = 0; ps < 4; ++ps) { const int t = ps * 16 + tr; r.a[ps] = (u32x2){0u, 0u}; r.b[ps] = r.a[ps]; r.c[ps] = r.a[ps];
        if (t < nq) { const bf16_t* pr = P + (size_t)(rowbase + t) * DIN + h * 128;
            if (mx == 0) { r.a[ps] = *(const u32x2*)(pr + c4 + C_FB); r.b[ps] = *(const u32x2*)(pr + c4 + C_QB); r.c[ps] = *(const u32x2*)(pr + c4 + C_IB); }
            else { r.a[ps] = *(const u32x2*)(pr + C_VC + c4); r.b[ps].x = *(const unsigned*)(pr + C_QC + i2); r.b[ps].y = *(const unsigned*)(pr + C_QC + 64 + i2); r.c[ps].x = *(const unsigned*)(pr + C_KC + i2); r.c[ps].y = *(const unsigned*)(pr + C_KC + 64 + i2); } } }
}
__device__ __forceinline__ void chunk_item(KP p, int l, int mx, int it, int it_next, ChunkRaw& raw, LAS unsigned char* lds, int tid) {
    const int lane = tid & 63, w = tid >> 6, fr = lane & 15, fq = lane >> 4;
    LAS float* G = (LAS float*)lds;
    LAS bf16_t* Qt = (LAS bf16_t*)(lds + 32768);
    LAS bf16_t* Kt = (LAS bf16_t*)(lds + 50176);
    LAS bf16_t* Vt = (LAS bf16_t*)(lds + 67584);
    LAS bf16_t* Kst = (LAS bf16_t*)(lds + 86016);
    LAS bf16_t* As = (LAS bf16_t*)(lds + 104448);
    LAS float* TOT = (LAS float*)(lds + 113664);
    const bf16_t* P = (const bf16_t*)(as_global(p->ws) + WS_P);
    float* INTRA = (float*)(as_global(p->ws) + WS_INTRA); bf16_t* QI = (bf16_t*)(as_global(p->ws) + WS_QI); float* LS = (float*)(as_global(p->ws) + WS_LS); float* DEC = (float*)(as_global(p->ws) + WS_DEC);
    const bool samp = it >= 520;
    int h, nq, rowbase, pos0;
    if (!samp) { const int seq = it / 65, c = it - seq * 65; const int b = seq >> 2; h = seq & 3; const int q0 = c ? 16 + 64 * (c - 1) : 0; nq = c ? 64 : 16; rowbase = b * LP + q0; pos0 = q0; }
    else { const int s = it - 520; const int b = s >> 2; h = s & 3; nq = 4; rowbase = NPROMPT + b * 4; pos0 = PAST; }
    const int c4 = (tid & 31) * 4, tr = tid >> 5;
    const float lgh = LG[h];
    if (mx == 0) {
        u32x2 rf[4], rq[4], ri[4];
#pragma unroll
        for (int ps = 0; ps < 4; ++ps) { rf[ps] = raw.a[ps]; rq[ps] = raw.b[ps]; ri[ps] = raw.c[ps]; }
        if (it_next < NITEM) chunk_load(p, 0, it_next, tid, raw);
        float lbv[4];
#pragma unroll
        for (int e = 0; e < 4; ++e) { float v = 0.f; if (l == 1) { const float a0 = as_global(p->hgrn_lb)[h * 128 + c4 + e], a1 = as_global(p->hgrn_lb)[512 + h * 128 + c4 + e]; v = 1.f / (1.f + expf(a0 - a1)); } lbv[e] = v; }
        f32x4 lf[4], kk[4];
#pragma unroll
        for (int ps = 0; ps < 4; ++ps) { const int t = ps * 16 + tr; lf[ps] = (f32x4){0.f, 0.f, 0.f, 0.f}; kk[ps] = lf[ps];
            if (t < nq) { const float z[4] = {bf_lo(rf[ps].x), bf_hi(rf[ps].x), bf_lo(rf[ps].y), bf_hi(rf[ps].y)};
#pragma unroll
                for (int e = 0; e < 4; ++e) { const float ez = __expf(-fabsf(z[e])), rc = __builtin_amdgcn_rcpf(1.f + ez); const float sp = (z[e] >= 0.f) ? rc : ez * rc, sm = (z[e] >= 0.f) ? ez * rc : rc;
                    const float om = 1.f - lbv[e]; lf[ps][e] = __logf(fmaxf(lbv[e], 1e-30f) + om * sp); kk[ps][e] = om * sm; } }
            *(LAS f32x4*)(G + t * 128 + c4) = lf[ps]; }
        LDS_SYNC();
        { const int seg = tid >> 7, k = tid & 127; float r[16]; float run = 0.f;
#pragma unroll
          for (int i = 0; i < 16; ++i) { run += G[(seg * 16 + i) * 128 + k]; r[i] = run; }
          TOT[seg * 128 + k] = run;
          LDS_SYNC();
          float off = 0.f;
#pragma unroll
          for (int s2 = 0; s2 < 3; ++s2) off += (s2 < seg) ? TOT[s2 * 128 + k] : 0.f;
#pragma unroll
          for (int i = 0; i < 16; ++i) G[(seg * 16 + i) * 128 + k] = r[i] + off; }
        LDS_SYNC();
        const f32x4 gm = *(const LAS f32x4*)(G + 31 * 128 + c4), gl = *(const LAS f32x4*)(G + 63 * 128 + c4);
        const f32x4 egm = {__expf(gm[0]), __expf(gm[1]), __expf(gm[2]), __expf(gm[3])}, eglm = {__expf(gl[0] - gm[0]), __expf(gl[1] - gm[1]), __expf(gl[2] - gm[2]), __expf(gl[3] - gm[3])};
#pragma unroll
        for (int ps = 0; ps < 4; ++ps) { const int t = ps * 16 + tr; const bool valid = t < nq;
            const float zq[4] = {bf_lo(rq[ps].x), bf_hi(rq[ps].x), bf_lo(rq[ps].y), bf_hi(rq[ps].y)}; const u32x2 iv = ri[ps];
            const f32x4 gg = *(const LAS f32x4*)(G + t * 128 + c4);
            float qt[4], kt[4], qi[4], ks4[4];
#pragma unroll
            for (int e = 0; e < 4; ++e) { const float kv = kk[ps][e]; const float q = valid ? siluf(zq[e]) : 0.f;
                const float dg = fminf(fmaxf(gg[e] - gm[e], -80.f), 80.f); const float ep = __expf(dg), en = __builtin_amdgcn_rcpf(ep);
                qt[e] = q * ep; kt[e] = kv * en; qi[e] = qt[e] * egm[e];
                ks4[e] = kt[e] * eglm[e]; }
            u32x2 w2; w2.x = pk2(qt[0], qt[1]); w2.y = pk2(qt[2], qt[3]); *(LAS u32x2*)(Qt + t * 136 + c4) = w2;
            w2.x = pk2(kt[0], kt[1]); w2.y = pk2(kt[2], kt[3]); *(LAS u32x2*)(Kt + t * 136 + c4) = w2;
            w2.x = pk2(ks4[0], ks4[1]); w2.y = pk2(ks4[2], ks4[3]); *(LAS u32x2*)(Kst + t * 136 + c4) = w2;
            *(LAS u32x2*)(Vt + t * 136 + c4) = iv;
            if (valid) { w2.x = pk2(qi[0], qi[1]); w2.y = pk2(qi[2], qi[3]); *(u32x2*)(QI + (size_t)(rowbase + t) * 1024 + h * 128 + c4) = w2; }
            if (t == 63) *(f32x4*)(DEC + (size_t)it * 128 + c4) = (f32x4){__expf(gl[0]), __expf(gl[1]), __expf(gl[2]), __expf(gl[3])}; }
    } else {
        const int i2 = (tid & 31) * 2;
        unsigned ra[4], rb[4], rc[4], rd[4]; u32x2 ri[4];
#pragma unroll
        for (int ps = 0; ps < 4; ++ps) { ri[ps] = raw.a[ps]; ra[ps] = raw.b[ps].x; rb[ps] = raw.b[ps].y; rc[ps] = raw.c[ps].x; rd[ps] = raw.c[ps].y; }
        if (it_next < NITEM) chunk_load(p, 1, it_next, tid, raw);
#pragma unroll
        for (int ps = 0; ps < 4; ++ps) { const int t = ps * 16 + tr; const bool valid = t < nq;
            const float q1[2] = {bf_lo(ra[ps]), bf_hi(ra[ps])}, q2[2] = {bf_lo(rb[ps]), bf_hi(rb[ps])}, k1[2] = {bf_lo(rc[ps]), bf_hi(rc[ps])}, k2[2] = {bf_lo(rd[ps]), bf_hi(rd[ps])}; const u32x2 iv = ri[ps];
            const float tail = valid ? __expf(lgh * (float)(nq - 1 - t)) : 0.f;
            float qa[2], qb[2], ka[2], kb[2];
#pragma unroll
            for (int e = 0; e < 2; ++e) { float s, c; sincos_red((float)(pos0 + t) * INV_C[i2 + e], s, c);
                qa[e] = q1[e] * c - q2[e] * s; qb[e] = q2[e] * c + q1[e] * s; ka[e] = (k1[e] * c - k2[e] * s) * 0.08838834764831845f; kb[e] = (k2[e] * c + k1[e] * s) * 0.08838834764831845f;
                }
            const unsigned qlo = pk2(qa[0], qa[1]), qhi = pk2(qb[0], qb[1]);
            *(LAS unsigned*)(Qt + t * 136 + i2) = qlo; *(LAS unsigned*)(Qt + t * 136 + 64 + i2) = qhi;
            *(LAS unsigned*)(Kt + t * 136 + i2) = pk2(ka[0], ka[1]); *(LAS unsigned*)(Kt + t * 136 + 64 + i2) = pk2(kb[0], kb[1]);
            *(LAS unsigned*)(Kst + t * 136 + i2) = pk2(ka[0] * tail, ka[1] * tail); *(LAS unsigned*)(Kst + t * 136 + 64 + i2) = pk2(kb[0] * tail, kb[1] * tail);
            *(LAS u32x2*)(Vt + t * 136 + c4) = iv;
            if (valid) { bf16_t* qr = QI + (size_t)(rowbase + t) * 1024 + 512 + h * 128; *(unsigned*)(qr + i2) = qlo; *(unsigned*)(qr + 64 + i2) = qhi; } }
    }
    LDS_SYNC();
    const int colo = mx * 512 + h * 128;
    if ((w >> 1) * 16 < nq) { const int qt = w >> 1, vh = w & 1, q = qt * 16 + fr;
      f32x4 at[4];
#pragma unroll
      for (int st = 0; st < 4; ++st) { f32x4 z = {0.f, 0.f, 0.f, 0.f};
          if (st <= qt) {
#pragma unroll
              for (int ks = 0; ks < 4; ++ks) z = MFMA16(frag(Kt, st * 16, 136, ks * 32, fr, fq), frag(Qt, qt * 16, 136, ks * 32, fr, fq), z);
#pragma unroll
              for (int i = 0; i < 4; ++i) { const int sI = st * 16 + 4 * fq + i; float v = (sI <= q) ? z[i] : 0.f; if (mx == 1) v *= __expf(lgh * (float)((sI <= q) ? (q - sI) : 0)); z[i] = v; } }
          at[st] = z; }
#pragma unroll
      for (int e = 0; e < 2; ++e) { const int vp = vh * 2 + e; f32x4 acc0 = {0.f, 0.f, 0.f, 0.f}, acc1 = {0.f, 0.f, 0.f, 0.f};
#pragma unroll
          for (int m = 0; m < 2; ++m) { if (2 * m <= qt) {
                  const u32x4 pw = {pk2(at[2 * m][0], at[2 * m][1]), pk2(at[2 * m][2], at[2 * m][3]), pk2(at[2 * m + 1][0], at[2 * m + 1][1]), pk2(at[2 * m + 1][2], at[2 * m + 1][3])};
                  const bf16x8 pb = __builtin_bit_cast(bf16x8, pw);
                  const LAS bf16_t* va = Vt + (32 * m + fq * 4 + ((lane >> 2) & 3)) * 136 + 32 * vp + 8 * (lane & 3);
                  const v4i16_t l0 = __builtin_amdgcn_ds_read_tr16_b64_v4i16((LAS v4i16_t*)va), h0 = __builtin_amdgcn_ds_read_tr16_b64_v4i16((LAS v4i16_t*)(va + 16 * 136));
                  const v4i16_t l1 = __builtin_amdgcn_ds_read_tr16_b64_v4i16((LAS v4i16_t*)(va + 4)), h1 = __builtin_amdgcn_ds_read_tr16_b64_v4i16((LAS v4i16_t*)(va + 16 * 136 + 4));
                  acc0 = MFMA16(((bf16x8){l0[0], l0[1], l0[2], l0[3], h0[0], h0[1], h0[2], h0[3]}), pb, acc0);
                  acc1 = MFMA16(((bf16x8){l1[0], l1[1], l1[2], l1[3], h1[0], h1[1], h1[2], h1[3]}), pb, acc1); } }
          if (q < nq) { u32x4 iw; iw.x = pk2(acc0[0], acc0[1]); iw.y = pk2(acc0[2], acc0[3]); iw.z = pk2(acc1[0], acc1[1]); iw.w = pk2(acc1[2], acc1[3]);
              *(u32x4*)((bf16_t*)INTRA + (size_t)(rowbase + q) * 1024 + colo + 32 * vp + 8 * fq) = iw; } } }
    bf16_t* ls = (bf16_t*)LS + ((size_t)mx * NITEM + it) * 16384;
#pragma unroll
    for (int vp = 0; vp < 4; ++vp) { f32x4 acc0 = {0.f, 0.f, 0.f, 0.f}, acc1 = {0.f, 0.f, 0.f, 0.f};
#pragma unroll
        for (int ks = 0; ks < 2; ++ks) { const bf16x8 kf = frag_tr(Kst, 136, ks * 32, w * 16, lane);
            const LAS bf16_t* va = Vt + (ks * 32 + (lane >> 4) * 8 + ((lane >> 2) & 3)) * 136 + 32 * vp + 8 * (lane & 3);
            const v4i16_t l0 = __builtin_amdgcn_ds_read_tr16_b64_v4i16((LAS v4i16_t*)va), h0 = __builtin_amdgcn_ds_read_tr16_b64_v4i16((LAS v4i16_t*)(va + 4 * 136));
            const v4i16_t l1 = __builtin_amdgcn_ds_read_tr16_b64_v4i16((LAS v4i16_t*)(va + 4)), h1 = __builtin_amdgcn_ds_read_tr16_b64_v4i16((LAS v4i16_t*)(va + 4 * 136 + 4));
            acc0 = MFMA16(((bf16x8){l0[0], l0[1], l0[2], l0[3], h0[0], h0[1], h0[2], h0[3]}), kf, acc0);
            acc1 = MFMA16(((bf16x8){l1[0], l1[1], l1[2], l1[3], h1[0], h1[1], h1[2], h1[3]}), kf, acc1); }
        u32x4 lw; lw.x = pk2(acc0[0], acc0[1]); lw.y = pk2(acc0[2], acc0[3]); lw.z = pk2(acc1[0], acc1[1]); lw.w = pk2(acc1[2], acc1[3]);
        *(u32x4*)(ls + (w * 16 + fr) * 128 + 32 * vp + 8 * fq) = lw; }
    LDS_SYNC();
}

struct FinRaw { u32x2 sw[8]; u32x4 qv[2]; u32x2 iv[4]; u32x4 g0, g1; };
__device__ __forceinline__ FinRaw finish_load(KP p, int l, int mx, int it, int tid) { FinRaw r;
    const int lane = tid & 63, w = tid >> 6, fr = lane & 15, fq = lane >> 4;
    const bf16_t* P = (const bf16_t*)(as_global(p->ws) + WS_P);
    const bf16_t* INTRA = (const bf16_t*)(as_global(p->ws) + WS_INTRA); const bf16_t* QI = (const bf16_t*)(as_global(p->ws) + WS_QI); const bf16_t* LSb = (const bf16_t*)(as_global(p->ws) + WS_LS);
    const bool samp = it >= 520;
    int h, nq, rowbase; const float* S = nullptr; const bf16_t* Sb = nullptr;
    if (!samp) { const int seq = it / 65, c = it - seq * 65; const int b = seq >> 2; h = seq & 3; const int q0 = c ? 16 + 64 * (c - 1) : 0; nq = c ? 64 : 16; rowbase = b * LP + q0;
        if (c) Sb = LSb + ((size_t)mx * NITEM + it - 1) * 16384; }
    else { const int s = it - 520; const int b = s >> 2; h = s & 3; nq = 4; rowbase = NPROMPT + b * 4; S = (mx ? as_global(p->state_ret) : as_global(p->state_hgrn)) + ((size_t)((l * 32 + b) * 4 + h)) * 16384; }
    const int colo = mx * 512 + h * 128;
    const int v4 = (tid & 31) * 4, kr = tid >> 5;
#pragma unroll
    for (int ps = 0; ps < 8; ++ps) { r.sw[ps] = (u32x2){0u, 0u};
        if (Sb) r.sw[ps] = *(const u32x2*)(Sb + (ps * 16 + kr) * 128 + v4);
        else if (S) { const f32x4 f = *(const f32x4*)(S + (ps * 16 + kr) * 128 + v4); r.sw[ps].x = pk2(f[0], f[1]); r.sw[ps].y = pk2(f[2], f[3]); } }
#pragma unroll
    for (int q = 0; q < 2; ++q) { const int idx = tid + q * 512, t = idx >> 4, ch = idx & 15; r.qv[q] = (u32x4){0u, 0u, 0u, 0u}; if (t < nq) r.qv[q] = *(const u32x4*)(QI + (size_t)(rowbase + t) * 1024 + colo + ch * 8); }
#pragma unroll
    for (int tt = 0; tt < 4; ++tt) { const int t = tt * 16 + fr; r.iv[tt] = (u32x2){0u, 0u}; if (t < nq) r.iv[tt] = *(const u32x2*)(INTRA + (size_t)(rowbase + t) * 1024 + colo + w * 16 + 4 * fq); }
    const int t8 = tid >> 3, part = tid & 7; r.g0 = (u32x4){0u, 0u, 0u, 0u}; r.g1 = r.g0;
    if (t8 < nq) { const bf16_t* gp = P + (size_t)(rowbase + t8) * DIN + (mx ? C_GC : C_GB) + h * 128 + part * 16; r.g0 = *(const u32x4*)gp; r.g1 = *(const u32x4*)(gp + 8); }
    return r;
}
__device__ __forceinline__ void finish_item(KP p, int l, int mx, int it, int it_next, int mx_next, FinRaw& raw, LAS unsigned char* lds, int tid) {
    const int lane = tid & 63, w = tid >> 6, fr = lane & 15, fq = lane >> 4;
    LAS bf16_t* St = (LAS bf16_t*)lds;
    LAS bf16_t* Qi = (LAS bf16_t*)(lds + 34816);
    LAS float* Ob = (LAS float*)(lds + 52224);
    const bf16_t* P = (const bf16_t*)(as_global(p->ws) + WS_P);
    const float* INTRA = (const float*)(as_global(p->ws) + WS_INTRA); const bf16_t* QI = (const bf16_t*)(as_global(p->ws) + WS_QI); const float* LS = (const float*)(as_global(p->ws) + WS_LS);
    bf16_t* MIX = (bf16_t*)(as_global(p->ws) + WS_ACT);
    const bool samp = it >= 520;
    int h, nq, rowbase; const float* S = nullptr; const bf16_t* Sb = nullptr;
    if (!samp) { const int seq = it / 65, c = it - seq * 65; const int b = seq >> 2; h = seq & 3; const int q0 = c ? 16 + 64 * (c - 1) : 0; nq = c ? 64 : 16; rowbase = b * LP + q0;
        if (c) Sb = (const bf16_t*)LS + ((size_t)mx * NITEM + it - 1) * 16384; }
    else { const int s = it - 520; const int b = s >> 2; h = s & 3; nq = 4; rowbase = NPROMPT + b * 4; S = (mx ? as_global(p->state_ret) : as_global(p->state_hgrn)) + ((size_t)((l * 32 + b) * 4 + h)) * 16384; }
    const int colo = mx * 512 + h * 128;
    const int v4 = (tid & 31) * 4, kr = tid >> 5;
    u32x2 sw[8]; u32x4 qv[2]; f32x4 iv[4]; u32x4 g0, g1;
#pragma unroll
    for (int ps = 0; ps < 8; ++ps) sw[ps] = raw.sw[ps];
    qv[0] = raw.qv[0]; qv[1] = raw.qv[1]; g0 = raw.g0; g1 = raw.g1;
#pragma unroll
    for (int tt = 0; tt < 4; ++tt) iv[tt] = (f32x4){bf_lo(raw.iv[tt].x), bf_hi(raw.iv[tt].x), bf_lo(raw.iv[tt].y), bf_hi(raw.iv[tt].y)};
    if (it_next >= 0) { int tid2 = tid; asm volatile("" : "+v"(tid2)); raw = finish_load(p, l, mx_next, it_next, tid2); }
    const int t8 = tid >> 3, part = tid & 7;
#pragma unroll
    for (int ps = 0; ps < 8; ++ps) { const int k = ps * 16 + kr; *(LAS u32x2*)(St + k * 136 + v4) = sw[ps]; }
#pragma unroll
    for (int r = 0; r < 2; ++r) { const int idx = tid + r * 512, t = idx >> 4, ch = idx & 15; *(LAS u32x4*)(Qi + t * 136 + ch * 8) = qv[r]; }
    LDS_SYNC();
    const float lgh = LG[h];
#pragma unroll
    for (int tt = 0; tt < 4; ++tt) { f32x4 acc = {0.f, 0.f, 0.f, 0.f};
#pragma unroll
        for (int ks = 0; ks < 4; ++ks) acc = MFMA16(frag_tr(St, 136, ks * 32, w * 16, lane), frag(Qi, tt * 16, 136, ks * 32, fr, fq), acc);
        const int t = tt * 16 + fr;
        if (mx == 1) acc = acc * __expf(lgh * (float)(t + 1));
        acc = acc + iv[tt];
        *(LAS f32x4*)(Ob + t * 132 + w * 16 + 4 * fq) = acc; }
    LDS_SYNC();
    { const int t = t8; const LAS float* orow = Ob + t * 132 + part * 16; float o[16]; float ss = 0.f;
#pragma unroll
      for (int j = 0; j < 4; ++j) { const f32x4 v = *(const LAS f32x4*)(orow + 4 * j); o[4 * j] = v[0]; o[4 * j + 1] = v[1]; o[4 * j + 2] = v[2]; o[4 * j + 3] = v[3]; ss += (v[0] * v[0] + v[1] * v[1]) + (v[2] * v[2] + v[3] * v[3]); }
      ss += __shfl_xor(ss, 1); ss += __shfl_xor(ss, 2); ss += __shfl_xor(ss, 4);
      if (t < nq) { const float r = rsqrtf(ss * (1.f / 128.f) + EPS); const float* nw = (mx ? as_global(p->ret_norm) : as_global(p->hgrn_norm)) + l * 128 + part * 16;
          const unsigned gw[8] = {g0.x, g0.y, g0.z, g0.w, g1.x, g1.y, g1.z, g1.w}; unsigned ow[8];
#pragma unroll
          for (int j = 0; j < 8; ++j) { const float a = o[2 * j] * r * nw[2 * j] * siluf(bf_lo(gw[j])), b2 = o[2 * j + 1] * r * nw[2 * j + 1] * siluf(bf_hi(gw[j])); ow[j] = pk2(a, b2); }
          bf16_t* mp = MIX + (size_t)(rowbase + t) * D + 1024 + colo + part * 16;
          *(u32x4*)mp = (u32x4){ow[0], ow[1], ow[2], ow[3]}; *(u32x4*)(mp + 8) = (u32x4){ow[4], ow[5], ow[6], ow[7]}; } }
    LDS_SYNC();
}

__device__ __forceinline__ void scan_phase(KP p, int l, int tid) {
    bf16_t* LS = (bf16_t*)(as_global(p->ws) + WS_LS); const float* DEC = (const float*)(as_global(p->ws) + WS_DEC);
#define LDB4(ptr) ({ const u32x2 _u = *(const u32x2*)(ptr); (f32x4){bf_lo(_u.x), bf_hi(_u.x), bf_lo(_u.y), bf_hi(_u.y)}; })
    const int gid = blockIdx.x * 512 + tid, gsz = gridDim.x * 512;
    for (int idx = gid; idx < 131072; idx += gsz) { const int mx = idx >> 16, seq = (idx >> 13) & 7, e2 = idx & 8191, k = e2 >> 6, h = seq & 3, b = seq >> 2;
        float s0 = 0.f, s1 = 0.f; bf16_t* base = LS + ((size_t)mx * NITEM + seq * 65) * 16384 + e2 * 2; const float* dp = DEC + (size_t)(seq * 65) * 128 + k;
        const float d16 = __expf(LG[h] * 16.f), d64 = __expf(LG[h] * 64.f);
        unsigned ls[13], ln[13]; float dd[13], dn[13];
#pragma unroll
        for (int j = 0; j < 13; ++j) { ls[j] = *(const unsigned*)(base + (size_t)j * 16384); dd[j] = mx ? (j ? d64 : d16) : dp[j * 128]; }
#pragma unroll 1
        for (int g5 = 0; g5 < 5; ++g5) {
            if (g5 < 4) {
#pragma unroll
                for (int j = 0; j < 13; ++j) { const int c = (g5 + 1) * 13 + j; ln[j] = *(const unsigned*)(base + (size_t)c * 16384); dn[j] = mx ? d64 : dp[c * 128]; } }
#pragma unroll
            for (int j = 0; j < 13; ++j) { const int c = g5 * 13 + j; s0 = s0 * dd[j] + bf_lo(ls[j]); s1 = s1 * dd[j] + bf_hi(ls[j]); *(unsigned*)(base + (size_t)c * 16384) = pk2(s0, s1); }
#pragma unroll
            for (int j = 0; j < 13; ++j) { ls[j] = ln[j]; dd[j] = dn[j]; }
        }
        float* o = as_global(p->out) + (mx ? O_SRP : O_SHP) + ((size_t)((l * 2 + b) * 4 + h)) * 16384 + e2 * 2; o[0] = s0; o[1] = s1; }
    for (int idx = gid; idx < 2 * 128 * 4096; idx += gsz) { const int mx = idx >> 19, s_ = (idx >> 12) & 127, e4 = idx & 4095, k = e4 >> 5, b = s_ >> 2, h = s_ & 3, it = 520 + s_;
        const size_t so = ((size_t)((l * 32 + b) * 4 + h)) * 16384 + e4 * 4;
        const f32x4 s0 = *(const f32x4*)((mx ? as_global(p->state_ret) : as_global(p->state_hgrn)) + so); const f32x4 ls = LDB4(LS + ((size_t)mx * NITEM + it) * 16384 + e4 * 4);
        const float d = mx ? __expf(LG[h] * 4.f) : DEC[(size_t)it * 128 + k];
        *(f32x4*)(as_global(p->out) + (mx ? O_SRS : O_SHS) + so) = s0 * d + ls; }
#undef LDB4
}

#define XB_TMO      128
#define XB_XCNT(j)  (256  + 64 * (j))
#define XB_XSUB(j)  (1280 + 64 * (j))
#define XB_XGEN(j)  (2304 + 64 * (j))
#define XB_TOP      3328
#define XB_TOPGEN   3392
#define XCD_BAR_WORDS 3456
#define XB_SPIN_CAP (1u << 18)
__device__ __forceinline__ unsigned xb_ld(unsigned* p)              { return __hip_atomic_load(p, __ATOMIC_RELAXED, __HIP_MEMORY_SCOPE_AGENT); }
__device__ __forceinline__ unsigned xb_add(unsigned* p, unsigned v) { return __hip_atomic_fetch_add(p, v, __ATOMIC_RELAXED, __HIP_MEMORY_SCOPE_AGENT); }
__device__ __forceinline__ unsigned xb_xcc_id() { return (unsigned)__builtin_amdgcn_s_getreg((3 << 11) | 20) & 0xFu; }
#define XB_SPIN(cond, bar) do { unsigned _sp = 0; while (cond) { __builtin_amdgcn_s_sleep(1); \
    if ((++_sp & 255u) == 0u) { if (xb_ld(&(bar)[XB_TMO])) break; if (_sp > XB_SPIN_CAP) { atomicAdd(&(bar)[XB_TMO], 1u); break; } } } } while (0)
struct XcdBarrier { unsigned* bar; unsigned x; volatile LAS unsigned* st; };
__device__ __forceinline__ XcdBarrier xcd_barrier_post(unsigned* bar, volatile LAS unsigned* st) {
    XcdBarrier b; b.bar = bar; b.x = xb_xcc_id(); b.st = st;
    if (threadIdx.x == 0) (void)xb_add(&bar[XB_XCNT(b.x)], 1u);
    return b;
}
__device__ __forceinline__ void xcd_barrier_complete(unsigned* bar, unsigned x, unsigned& nloc, unsigned& nx) {
    const unsigned G = gridDim.x * gridDim.y * gridDim.z;
    unsigned sum, cnt, mine, sp = 0u;
    for (;;) {
        sum = 0u; cnt = 0u; mine = 0u;
#pragma unroll
        for (unsigned j = 0; j < 16; ++j) { const unsigned c = xb_ld(&bar[XB_XCNT(j)]); sum += c; cnt += (c > 0u) ? 1u : 0u; mine = (j == x) ? c : mine; }
        if (sum == G) break;
        __builtin_amdgcn_s_sleep(1);
        if ((++sp & 255u) == 0u) { if (xb_ld(&bar[XB_TMO])) break; if (sp > XB_SPIN_CAP) { atomicAdd(&bar[XB_TMO], 1u); break; } }
    }
    nloc = mine > 0u ? mine : 1u; nx = cnt > 0u ? cnt : 1u;
}
__device__ __forceinline__ void xcd_barrier(const XcdBarrier& b, const int tid) {
    asm volatile("s_waitcnt vmcnt(0)" ::: "memory");
    __syncthreads();
    if (tid == 0) {
        unsigned* bar = b.bar;
        __builtin_amdgcn_s_waitcnt(0);
        unsigned nloc = b.st[0], nx = b.st[1];
        if (nloc == 0u) { xcd_barrier_complete(bar, b.x, nloc, nx); b.st[0] = nloc; b.st[1] = nx; }
        const unsigned old = xb_add(&bar[XB_XSUB(b.x)], 1u);
        const unsigned gen = old / nloc;
        if (old + 1u == (gen + 1u) * nloc) {
            __builtin_amdgcn_fence(__ATOMIC_RELEASE, "agent");
            asm volatile("s_waitcnt vmcnt(0)" ::: "memory");
            const unsigned og = xb_add(&bar[XB_TOP], 1u);
            const unsigned tg = og / nx;
            if (og + 1u == (tg + 1u) * nx) xb_add(&bar[XB_TOPGEN], 1u);
            else XB_SPIN(xb_ld(&bar[XB_TOPGEN]) == tg, bar);
            __builtin_amdgcn_fence(__ATOMIC_ACQUIRE, "agent");
            xb_add(&bar[XB_XGEN(b.x)], 1u);
            asm volatile("s_waitcnt vmcnt(0)" ::: "memory");
        } else {
            XB_SPIN(xb_ld(&bar[XB_XGEN(b.x)]) == gen, bar);
            __builtin_amdgcn_fence(__ATOMIC_ACQUIRE, "agent");
            asm volatile("s_waitcnt vmcnt(0)" ::: "memory");
        }
    }
    __syncthreads();
}

__global__ void __launch_bounds__(512, 2) hymba_fwd(Params p_arg) {
    KP p = (KP)__builtin_amdgcn_kernarg_segment_ptr();
    extern __shared__ __attribute__((aligned(16))) unsigned char lds_raw[];
    LAS unsigned char* lds = (LAS unsigned char*)lds_raw;
    cg::grid_group grid = cg::this_grid();
    volatile LAS unsigned* bst = (volatile LAS unsigned*)(lds + 147392);
    if (threadIdx.x < 2) bst[threadIdx.x] = 0u;
    const int wave_s = __builtin_amdgcn_readfirstlane(threadIdx.x >> 6);
    __syncthreads();
    const XcdBarrier xbar = xcd_barrier_post((unsigned*)(as_global(p->ws) + WS_CTL) + p->li * XCD_BAR_WORDS, bst);
    const int G = gridDim.x, bx = blockIdx.x;
    const int ph_lo = p->ph_lo, ph_hi = p->ph_hi;
    if (ph_lo < 0) grid.sync();
    KP p0 = p;
#pragma unroll 1
    for (int ph = ph_lo; ph < ph_hi; ++ph) {
        KP p = p0; asm volatile("" : "+s"(p));
        const int l = ph / 9, kind = ph - l * 9;
        int tid = wave_s * 64 + (int)__builtin_amdgcn_mbcnt_hi(~0u, __builtin_amdgcn_mbcnt_lo(~0u, 0u)); asm volatile("" : "+v"(tid));
        const int lane = tid & 63, wave = __builtin_amdgcn_readfirstlane(tid >> 6);
        unsigned char* wsb0 = p->ws; asm volatile("" : "+s"(wsb0)); unsigned char* wsb = as_global(wsb0);
        bf16_t* WT_IN = (bf16_t*)(wsb + (l ? WS_WIN2 : WS_WIN)); bf16_t* WT_OUT = (bf16_t*)(wsb + (l ? WS_WOUT2 : WS_WOUT)); bf16_t* WT_GU = (bf16_t*)(wsb + WS_WGU); bf16_t* WT_D = (bf16_t*)(wsb + (l ? WS_WD2 : WS_WD));
        const int remG1 = (33 * 22) % G, remG3 = (33 * 44) % G;
        float* X = (float*)(wsb + WS_X); bf16_t* ACT = (bf16_t*)(wsb + WS_ACT); bf16_t* Pb = (bf16_t*)(wsb + WS_P);
        if (ph == 18) {
            const int gid = bx * 512 + tid, gsz = G * 512;
            for (int idx = gid; idx < 160 * 512; idx += gsz) { const int row = 8192 + (idx >> 9), c4 = (idx & 511) * 4; f32x4 v = *(const f32x4*)(X + (size_t)row * D + c4);
                f32x4 t[11];
#pragma unroll
                for (int kp = 0; kp < 11; ++kp) t[kp] = *(const f32x4*)((const float*)(wsb + WS_LS) + ((size_t)kp * 160 + (row - 8192)) * D + c4);
#pragma unroll
                for (int kp = 0; kp < 11; ++kp) v = v + t[kp];
                float* o = (row < NPROMPT) ? as_global(p->out) + O_YP + ((size_t)(4096 + row - LP - 16)) * D + c4 : as_global(p->out) + O_YS + (size_t)(row - NPROMPT) * D + c4; *(f32x4*)o = v; }
        } else if (kind == 0) {
            LAS float* scr = (LAS float*)(lds + wave * 18432);
            const int gw = bx * 8 + wave, NGW = G * 8;
            constexpr int I_IN = 32 * 88, I_OUT = 32 * 32, I_G = 32 * 88, I_D = 88 * 32, NIT = I_IN + I_OUT + 2 * I_G + I_D;
            const bool skip_i = (l == 1) && remG1 != 0, skip_od = (l == 1) && remG3 != 0, skip_g = (l == 1) && G > 88, skip_d0 = (l == 0) && G > 32;
            for (int it = gw; it < NIT; it += NGW) { int r = it;
                if (r < I_IN) { if (!skip_i) transpose_item(as_global(p->w_in) + (size_t)l * D * DIN, D, DIN, WT_IN, 3, scr, r, lane); continue; } r -= I_IN;
                if (r < I_OUT) { if (!skip_od) transpose_item(as_global(p->w_out) + (size_t)l * D * D, D, D, WT_OUT, 0, scr, r, lane); continue; } r -= I_OUT;
                if (r < I_G) { if (!skip_g) transpose_item(as_global(p->w_gate) + (size_t)l * D * DFF, D, DFF, WT_GU, 1, scr, r, lane); continue; } r -= I_G;
                if (r < I_G) { transpose_item(as_global(p->w_up) + (size_t)l * D * DFF, D, DFF, WT_GU, 2, scr, r, lane); continue; } r -= I_G;
                if (!skip_od && !skip_d0) transpose_item(as_global(p->w_down) + (size_t)l * DFF * D, DFF, D, WT_D, 0, scr, r, lane); }
#define SRC_ROW(m) ((l == 0) ? (((m) < NPROMPT) ? ((((m) % LP) < 16) ? as_global(p->meta) + (size_t)((m) % LP) * D : as_global(p->x_prompt) + ((size_t)((m) / LP) * 4096 + ((m) % LP) - 16) * D) : (((m) < NTOK) ? as_global(p->x_sample) + (size_t)((m) - NPROMPT) * D : (const float*)nullptr)) : (const float*)(X + (size_t)(m) * D))
            for (int m = gw; m + NGW < 8192 + NGW && m < 8192; m += 2 * NGW) { const int m1 = m + NGW;
                if (m1 < 8192) norm_row2(SRC_ROW(m), SRC_ROW(m1), as_global(p->norm_mix) + l * D, ACT + (size_t)m * D, ACT + (size_t)m1 * D, nullptr, nullptr, lane);
                else norm_row(SRC_ROW(m), as_global(p->norm_mix) + l * D, ACT + (size_t)m * D, nullptr, lane, nullptr, 0); }
            for (int m = 8192 + gw; m < MP; m += NGW) { const float* src = SRC_ROW(m); float* xc = (l == 0) ? X + (size_t)m * D : nullptr;
                const bool tl = (l == 1) && m < NTOK;
                norm_row(src, as_global(p->norm_mix) + l * D, ACT + (size_t)m * D, tl ? X + (size_t)m * D : xc, lane, (const float*)(wsb + WS_LS) + (size_t)(tl ? m - 8192 : 0) * D, tl ? 11 : 0); }
#undef SRC_ROW
        } else if (kind == 1) {
            pg8::Gemm g{ACT, WT_IN, MP, DIN, D}; pg8::StaticOrder S; S.init(MP, DIN, D, G, bx, false); pg8::EpiBf16 E{Pb, DIN};
#ifndef NO_G1
            pg8::gemm_phase<pg8::EpiBf16>(lds, g, S, E, tid);
#endif
            if (l == 0 && remG1 != 0 && bx >= remG1) {
                LAS float* scr = (LAS float*)(lds + wave * 18432);
                for (int it = (bx - remG1) * 8 + wave; it < 32 * 88; it += (G - remG1) * 8) transpose_item(as_global(p->w_in) + (size_t)D * DIN, D, DIN, (bf16_t*)(wsb + WS_WIN2), 3, scr, it, lane); }
        } else if (kind == 2) {
#ifndef NO_ATTN
            { AttnRaw raw = attn_load(p, bx < 520 ? bx : 0, tid);
#pragma unroll 1
              for (int it = bx; it < NITEM; it += G) attn_item(p, l, it, it + G, raw, lds, tid); }
#endif
#ifndef NO_CHUNK
            { ChunkRaw raw; int it = (bx + G - (136 % G)) % G; chunk_load(p, 0, it < NITEM ? it : 0, tid, raw);
#pragma unroll 1
              for (; it < NITEM; it += G) chunk_item(p, l, 0, it, it + G, raw, lds, tid); }
            { ChunkRaw raw; int it = (bx + 2 * G - (272 % G)) % G; chunk_load(p, 1, it < NITEM ? it : 0, tid, raw);
#pragma unroll 1
              for (; it < NITEM; it += G) chunk_item(p, l, 1, it, it + G, raw, lds, tid); }
#endif
        } else if (kind == 3) {
#ifndef NO_SCAN
            scan_phase(p, l, tid);
#endif
        } else if (kind == 4) {
#ifndef NO_FIN
            { FinRaw raw = finish_load(p, l, bx < NITEM ? 0 : 1, bx < NITEM ? bx : bx - NITEM, tid); int it = bx;
#pragma unroll 1
              for (; it < 2 * NITEM; it += G) { const int nx = it + G; const bool hn = nx < 2 * NITEM; const int mxn = (nx < NITEM) ? 0 : 1, itn = hn ? (nx < NITEM ? nx : nx - NITEM) : -1;
                  finish_item(p, l, (it < NITEM) ? 0 : 1, (it < NITEM) ? it : it - NITEM, itn, mxn, raw, lds, tid); } }
#endif
        } else if (kind == 5 || kind == 8) {
            const int Kd = kind == 5 ? D : DFF;
            pg8::Gemm g{kind == 5 ? ACT : Pb, kind == 5 ? WT_OUT : WT_D, MP, D, Kd}; pg8::StaticOrder S; S.init(MP, D, Kd, G, bx, true);
            pg8::EpiResid E{p->dummy ? (float*)(wsb + WS_LS) + (size_t)16 * 160 * D : X, (kind == 8 && l == 1) ? as_global(p->out) : nullptr, Kd / 64, (float*)(wsb + WS_LS), as_global(p->meta), (kind == 5 && l == 0 && !p->dummy) ? as_global(p->x_prompt) : nullptr};
#ifndef NO_G24
            pg8::gemm_phase<pg8::EpiResid>(lds, g, S, E, tid);
#endif
            if (kind == 5 && l == 0 && G > 32 && bx >= 32) {
                LAS float* scr = (LAS float*)(lds + wave * 18432);
                for (int it = (bx - 32) * 8 + wave; it < 88 * 32; it += (G - 32) * 8) transpose_item(as_global(p->w_down), DFF, D, (bf16_t*)(wsb + WS_WD), 0, scr, it, lane); }
            if (kind == 8 && l == 0 && G > 88 && bx >= 88) {
                LAS float* scr = (LAS float*)(lds + wave * 18432);
                for (int it = (bx - 88) * 8 + wave; it < 32 * 88; it += (G - 88) * 8) transpose_item(as_global(p->w_gate) + (size_t)D * DFF, D, DFF, WT_GU, 1, scr, it, lane); }
        } else if (kind == 6) {
            const int gw = bx * 8 + wave, NGW = G * 8;
            for (int m = gw; m < 8192; m += 2 * NGW) { const int m1 = m + NGW;
                if (m1 < 8192) norm_row2(X + (size_t)m * D, X + (size_t)m1 * D, as_global(p->norm_ffn) + l * D, ACT + (size_t)m * D, ACT + (size_t)m1 * D, nullptr, nullptr, lane);
                else norm_row(X + (size_t)m * D, as_global(p->norm_ffn) + l * D, ACT + (size_t)m * D, nullptr, lane, nullptr, 0); }
            for (int m = 8192 + gw; m < MP; m += NGW) { const bool tl = m < NTOK;
                norm_row(m < NTOK ? X + (size_t)m * D : nullptr, as_global(p->norm_ffn) + l * D, ACT + (size_t)m * D, tl ? X + (size_t)m * D : nullptr, lane, (const float*)(wsb + WS_LS) + (size_t)(tl ? m - 8192 : 0) * D, tl ? 4 : 0); }
        } else {
            pg8::Gemm g{ACT, WT_GU, MP, 2 * DFF, D}; pg8::StaticOrder S; S.init(MP, 2 * DFF, D, G, bx, false); pg8::EpiSwiglu E{Pb};
#ifndef NO_G3
            pg8::gemm_phase<pg8::EpiSwiglu>(lds, g, S, E, tid);
#endif
            if (l == 0 && remG3 != 0 && bx >= remG3) {
                LAS float* scr = (LAS float*)(lds + wave * 18432);
                for (int it = (bx - remG3) * 8 + wave; it < 32 * 32 + 88 * 32; it += (G - remG3) * 8) {
                    if (it < 32 * 32) transpose_item(as_global(p->w_out) + (size_t)D * D, D, D, (bf16_t*)(wsb + WS_WOUT2), 0, scr, it, lane);
                    else transpose_item(as_global(p->w_down) + (size_t)DFF * D, DFF, D, (bf16_t*)(wsb + WS_WD2), 0, scr, it - 32 * 32, lane); } }
        }
        if (ph + 1 < ph_hi) xcd_barrier(xbar, tid);
    }
}

extern "C" void kernel_launch(void* const* d_in, const int* in_sizes, int n_in, void* d_out, int out_size, void* d_ws, size_t ws_size, hipStream_t stream) {
    static int grid = 0;
    if (grid == 0) {
        int dev = 0, cus = 0, per_cu = 0;
        hipGetDevice(&dev); hipDeviceGetAttribute(&cus, hipDeviceAttributeMultiprocessorCount, dev);
        hipFuncSetAttribute((const void*)hymba_fwd, hipFuncAttributeMaxDynamicSharedMemorySize, LDS_BYTES);
        hipOccupancyMaxActiveBlocksPerMultiprocessor(&per_cu, (const void*)hymba_fwd, 512, LDS_BYTES);
        if (per_cu < 1) { fprintf(stderr, "occupancy query says %d blocks/CU\n", per_cu); per_cu = 1; }
        if (per_cu > 1) per_cu = 1;
        grid = cus * per_cu;
        if (ws_size < WS_END) fprintf(stderr, "workspace too small: %zu < %zu\n", ws_size, (size_t)WS_END);
    }
    if (hipMemsetAsync((char*)d_ws + WS_CTL, 0, CTL_BYTES, stream) != hipSuccess) { fprintf(stderr, "memset failed\n"); return; }
    Params p{};
    const float** pp = (const float**)&p;
    for (int i = 0; i < 20; ++i) pp[i] = (const float*)d_in[i];
    p.out = (float*)d_out; p.ws = (unsigned char*)d_ws;
#ifdef REP_PH
    { const int cuts[4][3] = {{0, REP_PH + 1, 0}, {REP_PH, REP_PH + 1, 1}, {REP_PH + 1, 19, 0}};
      for (int i = 0; i < 3; ++i) { p.ph_lo = cuts[i][0]; p.ph_hi = cuts[i][1]; p.dummy = cuts[i][2]; p.li = i; void* args[] = {&p};
        hipError_t e = hipLaunchCooperativeKernel((const void*)hymba_fwd, dim3(grid), dim3(512), args, LDS_BYTES, stream);
        if (e != hipSuccess) { fprintf(stderr, "launch failed: %s\n", hipGetErrorString(e)); break; } } }
#else
    p.ph_lo = 0; p.ph_hi = 19; void* args[] = {&p};
    hipError_t e = hipLaunchCooperativeKernel((const void*)hymba_fwd, dim3(grid), dim3(512), args, LDS_BYTES, stream);
    if (e != hipSuccess) fprintf(stderr, "cooperative launch failed: %s (grid %d)\n", hipGetErrorString(e), grid);
#endif
}
```
